# Optimizing an MI355X kernel written in HIP

```python
import math
import jax, jax.numpy as jnp
from jax import lax
import numpy as np

D_MODEL = 2048
BATCH = 8
SEQ = 2048
DEPTH = 2

HEAD_DIM = 128
N_HEADS = D_MODEL // HEAD_DIM
N_SB_HEADS = N_HEADS // 2
N_FOX_HEADS = N_HEADS - N_SB_HEADS
D_FF = 256 * ((8 * D_MODEL // 3 + 255) // 256)
Q_BLOCK = 128
ROPE_THETA = 500000.0
ROPE_DIMS = HEAD_DIM // 4
DILATED_PATTERNS = ((128, 1), (512, 4), (2048, 16))
RMS_EPS = 1e-6
NEG_INF = -1e30
N_EVEN = (DEPTH + 1) // 2
N_ODD = DEPTH // 2

kernel_name = "hybrid_sb_fox_dilated_macaron"


def rmsnorm(x, g):
    xf = x.astype(jnp.float32)
    y = xf * lax.rsqrt(jnp.mean(xf * xf, axis=-1, keepdims=True) + RMS_EPS)
    return (y * g.astype(jnp.float32)).astype(x.dtype)


def swiglu(x, w_gate, w_up, w_down):
    return (jax.nn.silu(x @ w_gate) * (x @ w_up)) @ w_down


def partial_rope(x, positions):
    half = ROPE_DIMS // 2
    freqs = ROPE_THETA ** (-jnp.arange(half, dtype=jnp.float32) / half)
    ang = positions[:, None] * freqs[None, :]
    cos = jnp.cos(ang)[None, :, None, :]
    sin = jnp.sin(ang)[None, :, None, :]
    xr = x[..., :ROPE_DIMS].astype(jnp.float32)
    x1, x2 = xr[..., :half], xr[..., half:]
    rot = jnp.concatenate([x1 * cos - x2 * sin, x2 * cos + x1 * sin], axis=-1)
    return jnp.concatenate([rot.astype(x.dtype), x[..., ROPE_DIMS:]], axis=-1)


def stick_breaking_attention(q, k, v):
    B, H, S, hd = q.shape
    n_blocks = S // Q_BLOCK
    scale = hd ** -0.5
    key_pos = jnp.arange(S)

    def block(i):
        qb = lax.dynamic_slice_in_dim(q, i * Q_BLOCK, Q_BLOCK, axis=2)
        z = jnp.einsum('bhqd,bhkd->bhqk', qb, k).astype(jnp.float32) * scale
        q_pos = i * Q_BLOCK + jnp.arange(Q_BLOCK)
        strict = key_pos[None, :] < q_pos[:, None]
        log_not_beta = jnp.where(strict, -jax.nn.softplus(z), 0.0)
        after = lax.cumsum(log_not_beta, axis=3, reverse=True) - log_not_beta
        w = jnp.where(strict, jnp.exp(jax.nn.log_sigmoid(z) + after), 0.0)
        return jnp.einsum('bhqk,bhkd->bhqd', w.astype(v.dtype), v)

    out = lax.map(block, jnp.arange(n_blocks))
    return jnp.moveaxis(out, 0, 2).reshape(B, H, S, hd)


def forgetting_attention(q, k, v, log_f):
    B, H, S, hd = q.shape
    n_blocks = S // Q_BLOCK
    scale = hd ** -0.5
    cum_f = lax.cumsum(log_f, axis=2)
    key_pos = jnp.arange(S)

    def block(i):
        qb = lax.dynamic_slice_in_dim(q, i * Q_BLOCK, Q_BLOCK, axis=2)
        fq = lax.dynamic_slice_in_dim(cum_f, i * Q_BLOCK, Q_BLOCK, axis=2)
        z = (jnp.einsum('bhqd,bhkd->bhqk', qb, k).astype(jnp.float32) * scale
             + fq[..., :, None] - cum_f[:, :, None, :])
        q_pos = i * Q_BLOCK + jnp.arange(Q_BLOCK)
        causal = key_pos[None, :] <= q_pos[:, None]
        p = jax.nn.softmax(jnp.where(causal, z, NEG_INF), axis=-1)
        return jnp.einsum('bhqk,bhkd->bhqd', p.astype(v.dtype), v)

    out = lax.map(block, jnp.arange(n_blocks))
    return jnp.moveaxis(out, 0, 2).reshape(B, H, S, hd)


def dilated_branch(q, k, v, window, dilation):
    B, S, H, hd = q.shape
    steps = window // dilation
    L = S // dilation
    n_blocks = -(-L // steps)
    Lp = n_blocks * steps
    scale = hd ** -0.5

    def to_sub(t):
        return t.reshape(B, L, dilation, H, hd).transpose(0, 2, 3, 1, 4)

    qs = jnp.pad(to_sub(q), ((0, 0), (0, 0), (0, 0), (0, Lp - L), (0, 0)))
    qs = qs.reshape(B, dilation, H, n_blocks, steps, hd)

    def banded(t):
        tp = jnp.pad(to_sub(t), ((0, 0), (0, 0), (0, 0), (steps, Lp - L), (0, 0)))
        prev = tp[:, :, :, :Lp].reshape(B, dilation, H, n_blocks, steps, hd)
        cur = tp[:, :, :, steps:].reshape(B, dilation, H, n_blocks, steps, hd)
        return jnp.concatenate([prev, cur], axis=4)

    kb, vb = banded(k), banded(v)
    z = jnp.einsum('brhnqd,brhnkd->brhnqk', qs, kb).astype(jnp.float32) * scale
    a = jnp.arange(steps)[:, None]
    c = jnp.arange(2 * steps)[None, :]
    dist = a + steps - c
    key_sub = jnp.arange(n_blocks)[:, None, None] * steps + c - steps
    valid = (dist >= 0) & (dist <= steps) & (key_sub >= 0)
    z = jnp.where(valid, z, NEG_INF)
    m = jnp.max(z, axis=-1, keepdims=True)
    e = jnp.exp(z - m)
    denom = jnp.sum(e, axis=-1, keepdims=True)
    o = jnp.einsum('brhnqk,brhnkd->brhnqd', (e / denom).astype(v.dtype), vb)
    lse = (m + jnp.log(denom))[..., 0]
    o = o.reshape(B, dilation, H, Lp, hd)[:, :, :, :L]
    o = o.transpose(0, 3, 1, 2, 4).reshape(B, S, H, hd)
    lse = lse.reshape(B, dilation, H, Lp)[..., :L].transpose(0, 3, 1, 2).reshape(B, S, H)
    return o, lse


def dilated_attention(q, k, v):
    outs, lses = [], []
    for window, dilation in DILATED_PATTERNS:
        o, lse = dilated_branch(q, k, v, window, dilation)
        outs.append(o)
        lses.append(lse)
    w = jax.nn.softmax(jnp.stack(lses, axis=0), axis=0)
    out = jnp.sum(w[..., None] * jnp.stack(outs, axis=0).astype(jnp.float32), axis=0)
    return out.astype(q.dtype)


def sb_fox_mixer(x, w_in, b_forget, w_out):
    B, S, _ = x.shape
    h = x @ w_in
    qkv = h[..., :3 * D_MODEL].reshape(B, S, 3, N_HEADS, HEAD_DIM).transpose(2, 0, 3, 1, 4)
    q, k, v = qkv[0], qkv[1], qkv[2]
    log_f = jax.nn.log_sigmoid(
        (h[..., 3 * D_MODEL:] + b_forget).astype(jnp.float32)).transpose(0, 2, 1)
    o_sb = stick_breaking_attention(q[:, :N_SB_HEADS], k[:, :N_SB_HEADS], v[:, :N_SB_HEADS])
    o_fox = forgetting_attention(q[:, N_SB_HEADS:], k[:, N_SB_HEADS:], v[:, N_SB_HEADS:], log_f)
    o = jnp.concatenate([o_sb, o_fox], axis=1).transpose(0, 2, 1, 3).reshape(B, S, D_MODEL)
    return o @ w_out


def dilated_mixer(x, w_qkv, w_out):
    B, S, _ = x.shape
    qkv = (x @ w_qkv).reshape(B, S, 3, N_HEADS, HEAD_DIM)
    positions = jnp.arange(S, dtype=jnp.float32)
    q = partial_rope(qkv[:, :, 0], positions)
    k = partial_rope(qkv[:, :, 1], positions)
    v = qkv[:, :, 2]
    o = dilated_attention(q, k, v).reshape(B, S, D_MODEL)
    return o @ w_out


def setup_inputs(seed: int = 0) -> dict:
    key = jax.random.key(seed)
    ks = jax.random.split(key, 16)
    f32 = jnp.float32

    def dense(k, shape, fan_in):
        return jax.random.normal(k, shape, f32) * fan_in ** -0.5

    x = jax.random.normal(ks[0], (BATCH, SEQ, D_MODEL), f32)
    norm_g = 1.0 + 0.02 * jax.random.normal(ks[1], (DEPTH, 3, D_MODEL), f32)
    ffn1_w_gate = dense(ks[2], (DEPTH, D_MODEL, D_FF), D_MODEL)
    ffn1_w_up = dense(ks[3], (DEPTH, D_MODEL, D_FF), D_MODEL)
    ffn1_w_down = dense(ks[4], (DEPTH, D_FF, D_MODEL), D_FF)
    ffn2_w_gate = dense(ks[5], (DEPTH, D_MODEL, D_FF), D_MODEL)
    ffn2_w_up = dense(ks[6], (DEPTH, D_MODEL, D_FF), D_MODEL)
    ffn2_w_down = dense(ks[7], (DEPTH, D_FF, D_MODEL), D_FF)
    even_w_in = dense(ks[8], (N_EVEN, D_MODEL, 3 * D_MODEL + N_FOX_HEADS), D_MODEL)
    even_b_forget = 3.0 + 0.5 * jax.random.normal(ks[9], (N_EVEN, N_FOX_HEADS), f32)
    even_w_out = dense(ks[10], (N_EVEN, D_MODEL, D_MODEL), D_MODEL)
    odd_w_qkv = dense(ks[11], (N_ODD, D_MODEL, 3 * D_MODEL), D_MODEL)
    odd_w_out = dense(ks[12], (N_ODD, D_MODEL, D_MODEL), D_MODEL)
    final_norm_g = 1.0 + 0.02 * jax.random.normal(ks[13], (D_MODEL,), f32)
    return {
        "x": x, "norm_g": norm_g,
        "ffn1_w_gate": ffn1_w_gate, "ffn1_w_up": ffn1_w_up, "ffn1_w_down": ffn1_w_down,
        "ffn2_w_gate": ffn2_w_gate, "ffn2_w_up": ffn2_w_up, "ffn2_w_down": ffn2_w_down,
        "even_w_in": even_w_in, "even_b_forget": even_b_forget, "even_w_out": even_w_out,
        "odd_w_qkv": odd_w_qkv, "odd_w_out": odd_w_out, "final_norm_g": final_norm_g,
    }


def reference(x, norm_g, ffn1_w_gate, ffn1_w_up, ffn1_w_down, ffn2_w_gate, ffn2_w_up,
              ffn2_w_down, even_w_in, even_b_forget, even_w_out, odd_w_qkv, odd_w_out,
              final_norm_g):
    for layer in range(DEPTH):
        j = layer // 2
        x = x + 0.5 * swiglu(rmsnorm(x, norm_g[layer, 0]),
                             ffn1_w_gate[layer], ffn1_w_up[layer], ffn1_w_down[layer])
        h = rmsnorm(x, norm_g[layer, 1])
        if layer % 2 == 0:
            x = x + sb_fox_mixer(h, even_w_in[j], even_b_forget[j], even_w_out[j])
        else:
            x = x + dilated_mixer(h, odd_w_qkv[j], odd_w_out[j])
        x = x + 0.5 * swiglu(rmsnorm(x, norm_g[layer, 2]),
                             ffn2_w_gate[layer], ffn2_w_up[layer], ffn2_w_down[layer])
    return rmsnorm(x, final_norm_g)
```

```cpp
#include <hip/hip_runtime.h>
#include <hip/hip_cooperative_groups.h>
#include <cstdio>
#include <cstring>
#include <cmath>
namespace cg = cooperative_groups;

#ifndef MK_SINGLE
#define MK_SINGLE 1
#endif

#ifndef EN_P0
#define EN_P0 1
#endif
#ifndef EN_FIN
#define EN_FIN 1
#endif
#ifndef EN_GU
#define EN_GU 1
#endif
#ifndef EN_RES
#define EN_RES 1
#endif
#ifndef EN_QKV
#define EN_QKV 1
#endif
#ifndef EN_ATT0
#define EN_ATT0 1
#endif
#ifndef EN_ATT1
#define EN_ATT1 1
#endif
#ifndef QKV_PARTS
#define QKV_PARTS 7
#endif
#ifndef ATT_PARTS
#define ATT_PARTS 3
#endif
#define LAS __attribute__((address_space(3)))
#define GAS __attribute__((address_space(1)))
#define DI __device__ __forceinline__

typedef unsigned short bf16_t;
typedef short bf16x8 __attribute__((ext_vector_type(8)));
typedef float f32x4 __attribute__((ext_vector_type(4)));
typedef unsigned u32x4 __attribute__((ext_vector_type(4)));
typedef unsigned u32x2 __attribute__((ext_vector_type(2)));

constexpr float EPS = 1e-6f, LOG2E = 1.4426950408889634f, LN2 = 0.6931471805599453f, SCALE = 0.08838834764831845f;
constexpr int LDS_BYTES = 131072;

constexpr size_t WS_SS = 0;
constexpr size_t WS_LOGF = 0x80000;
constexpr size_t WS_COS = 0x100000;
constexpr size_t WS_SIN = 0x120000;
constexpr size_t WS_WF = 0x140000;
constexpr size_t WS_WGU = 0x200000;
constexpr size_t SZ_WGU = (size_t)11264 * 2048 * 2;
constexpr size_t WS_WD = WS_WGU + 4 * SZ_WGU;
constexpr size_t SZ_WD = (size_t)2048 * 5632 * 2;
constexpr size_t WS_WQKV = WS_WD + 4 * SZ_WD;
constexpr size_t SZ_WQKV = (size_t)6144 * 2048 * 2;
constexpr size_t WS_WOUT = WS_WQKV + 2 * SZ_WQKV;
constexpr size_t SZ_WOUT = (size_t)2048 * 2048 * 2;
constexpr size_t WS_XB = WS_WOUT + 2 * SZ_WOUT;
constexpr size_t SZ_ACT = (size_t)16384 * 2048 * 2;
constexpr size_t WS_AO = WS_XB + SZ_ACT;
constexpr size_t WS_BIG = WS_AO + SZ_ACT;
constexpr size_t WS_VT = WS_BIG + (size_t)16384 * 4096 * 2;
constexpr size_t WS_END = WS_BIG + (size_t)16384 * 6144 * 2;

struct Params {
    const float* x; const float* norm_g;
    const float* f1g; const float* f1u; const float* f1d;
    const float* f2g; const float* f2u; const float* f2d;
    const float* ewin; const float* ebf; const float* ewout;
    const float* oqkv; const float* owout; const float* fng;
    float* out; unsigned char* ws;
    float freq[16];
    int ph_lo, ph_hi;
};

DI unsigned cvt_pk_bf16(float lo, float hi) { unsigned r; asm("v_cvt_pk_bf16_f32 %0, %1, %2" : "=v"(r) : "v"(lo), "v"(hi)); return r; }
DI int phase_tid() { int t = threadIdx.x; asm volatile("" : "+v"(t)); return t; }
DI float fexp2(float x) { return __builtin_amdgcn_exp2f(x); }
DI float flog2(float x) { return __builtin_amdgcn_logf(x); }
DI float frcp(float x) { return __builtin_amdgcn_rcpf(x); }
DI float rowscale(float ss) { return __builtin_amdgcn_rsqf(ss * (1.0f / 2048.0f) + EPS); }

namespace pg8 {
constexpr int BM = 256, BK = 64, HALF = 128, HTB = HALF * BK * 2, STAGE_BYTES = 8 * HTB, NXCD = 8, WGM = 8;
__host__ __device__ __forceinline__ int lds_byte(int r, int c) { const int st = (r >> 4) * 2 + (c >> 5), rr = r & 15, cc = c & 31, ob = rr * 64 + cc * 2; return st * 1024 + (ob ^ (((ob >> 9) & 1) << 5)); }
__host__ __device__ __forceinline__ void stage_rc(int b, int& R, int& C) { const int st = b / 1024, sb = b % 1024, swz = sb ^ (((sb >> 9) & 1) << 5); R = (st >> 1) * 16 + swz / 64; C = (st & 1) * 32 + (swz % 64) / 2; }
__host__ __device__ __forceinline__ int perm32(int rho) { const int n = rho >> 4, i = rho & 15; return 8 * (i >> 2) + 4 * n + (i & 3); }
struct Unit { int pm, pn; };
struct StaticOrder {
    int nM, nN, nwg, G, c;
    __device__ void init(int M, int N, int G_, int c_) { nM = M / BM; nN = N / BM; nwg = nM * nN; G = G_; c = c_; }
    __device__ bool next(int i, Unit& u) const {
        const long L = (long)i * G + c; if (L >= nwg) return false;
        int wgid = (int)L; { const int q = nwg / NXCD, r = nwg % NXCD, xcd = wgid % NXCD, off = wgid / NXCD; wgid = (xcd < r ? xcd * (q + 1) : r * (q + 1) + (xcd - r) * q) + off; }
        const int nig = WGM * nN, gid = wgid / nig, fm = gid * WGM, gsz = (nM - fm) < WGM ? (nM - fm) : WGM;
        u.pm = fm + ((wgid % nig) % gsz); u.pn = (wgid % nig) / gsz; return true;
    }
};

template <class Epi, bool FLIP>
DI void gemm_phase(LAS unsigned char* lds, const bf16_t* gA, const bf16_t* gBt, int M, int N, int K, const Epi& E) {
    const int tid = phase_tid(), wid = __builtin_amdgcn_readfirstlane(tid >> 6), lane = tid & 63, wr = wid >> 2, wc = wid & 3, fr = lane & 15, fq = lane >> 4;
    const int nt = K / BK;
    StaticOrder S; S.init(M, N, (int)gridDim.x, (int)blockIdx.x);
    unsigned voffA[2], voffB[2];
#pragma unroll
    for (int i = 0; i < 2; ++i) { int R, C; stage_rc(tid * 16 + i * 8192, R, C); const int Rb = Epi::PERM ? ((R & ~31) + perm32(R & 31)) : R;
        voffA[i] = (unsigned)(R * K + C) * 2u; voffB[i] = (unsigned)(Rb * K + C) * 2u; }
    const size_t kstep = (size_t)(BK * 2);
    const size_t hstep = (size_t)HALF * K * 2;
    const size_t tstep = 2 * hstep;
    const unsigned ldsw = (unsigned)wid * 1024u;
    const int aoff = lds_byte(wr * 64 + fr, fq * 8), boff = lds_byte(wc * 32 + fr, fq * 8);
#define PG8_SA(b, h) (((b) * 2 + (h)) * HTB)
#define PG8_SB(b, h) ((4 + (b) * 2 + (h)) * HTB)
#define PG8_STAGE(bufoff, gbase, voff) do { _Pragma("unroll") for (int _i = 0; _i < 2; ++_i) \
        __builtin_amdgcn_global_load_lds((const unsigned*)((const char*)(gbase) + (voff)[_i]), (LAS unsigned*)(lds + (bufoff) + ldsw + _i * 8192), 16, 0, 0); } while (0)
#define PG8_LDA(dst, b, h) do { _Pragma("unroll") for (int m = 0; m < 4; ++m) _Pragma("unroll") for (int k = 0; k < 2; ++k) dst[m][k] = *(const LAS bf16x8*)(lds + PG8_SA(b, h) + aoff + m * 2048 + k * 1024); } while (0)
#define PG8_LDB(dst, b, h) do { _Pragma("unroll") for (int n = 0; n < 2; ++n) _Pragma("unroll") for (int k = 0; k < 2; ++k) dst[n][k] = *(const LAS bf16x8*)(lds + PG8_SB(b, h) + boff + n * 2048 + k * 1024); } while (0)
#define PG8_MMA(ai, bj, At, Bt) do { __builtin_amdgcn_s_setprio(1); _Pragma("unroll") for (int m = 0; m < 4; ++m) _Pragma("unroll") for (int n = 0; n < 2; ++n) _Pragma("unroll") for (int k = 0; k < 2; ++k) \
        acc[ai][bj][m][n] = FLIP ? __builtin_amdgcn_mfma_f32_16x16x32_bf16(At[m][k], Bt[n][k], acc[ai][bj][m][n], 0, 0, 0) \
                                 : __builtin_amdgcn_mfma_f32_16x16x32_bf16(Bt[n][k], At[m][k], acc[ai][bj][m][n], 0, 0, 0); __builtin_amdgcn_s_setprio(0); } while (0)
#define PG8_WAIT_V(n) asm volatile("s_waitcnt vmcnt(" #n ")" ::: "memory")
#define PG8_WAIT_L(n) asm volatile("s_waitcnt lgkmcnt(" #n ")" ::: "memory")
#define PG8_BAR __builtin_amdgcn_s_barrier()
#define PG8_SCHED __builtin_amdgcn_sched_barrier(0)
    Unit cur, nxt; int ui = 0;
    if (!S.next(0, cur)) return;
    f32x4 acc[2][2][4][2];
#pragma unroll
    for (int a = 0; a < 2; ++a)
#pragma unroll
        for (int b = 0; b < 2; ++b)
#pragma unroll
            for (int m = 0; m < 4; ++m)
#pragma unroll
                for (int n = 0; n < 2; ++n) acc[a][b][m][n] = (f32x4){0.f, 0.f, 0.f, 0.f};
    bf16x8 At[4][2], B0[2][2], B1[2][2];
    const char* cA = (const char*)gA + (size_t)cur.pm * tstep; const char* cB = (const char*)gBt + (size_t)cur.pn * tstep;
    PG8_STAGE(PG8_SB(0, 0), cB, voffB); PG8_STAGE(PG8_SB(0, 1), cB + hstep, voffB); PG8_STAGE(PG8_SA(0, 0), cA, voffA); PG8_STAGE(PG8_SA(0, 1), cA + hstep, voffA);
    if (wr == 1) PG8_BAR;
    PG8_WAIT_V(2); PG8_BAR;
    PG8_STAGE(PG8_SB(1, 0), cB + kstep, voffB); PG8_STAGE(PG8_SA(1, 0), cA + kstep, voffA); PG8_STAGE(PG8_SB(1, 1), cB + hstep + kstep, voffB);
    PG8_WAIT_V(6); PG8_BAR;
    for (;;) {
        const bool has_next = S.next(ui + 1, nxt);
        const char* nA = has_next ? (const char*)gA + (size_t)nxt.pm * tstep : cA; const char* nB = has_next ? (const char*)gBt + (size_t)nxt.pn * tstep : cB;
        for (int t = 0; t < nt; t += 2) {
            const bool last = (t == nt - 2);
            const char* a1 = cA + (size_t)(t + 1) * kstep;
            const char* a2 = last ? nA : cA + (size_t)(t + 2) * kstep; const char* b2 = last ? nB : cB + (size_t)(t + 2) * kstep;
            const char* a3 = a2 + kstep; const char* b3 = b2 + kstep;
            PG8_LDB(B0, 0, 0); PG8_LDB(B1, 0, 1); PG8_SCHED; PG8_LDA(At, 0, 0); PG8_STAGE(PG8_SA(1, 1), a1 + hstep, voffA);
            PG8_WAIT_V(8); PG8_WAIT_L(0); PG8_BAR; PG8_MMA(0, 0, At, B0); PG8_MMA(0, 1, At, B1); PG8_BAR; PG8_SCHED;
            PG8_LDA(At, 0, 1); PG8_STAGE(PG8_SB(0, 0), b2, voffB); PG8_STAGE(PG8_SB(0, 1), b2 + hstep, voffB); PG8_STAGE(PG8_SA(0, 0), a2, voffA);
            PG8_WAIT_V(8); PG8_WAIT_L(0); PG8_BAR; PG8_MMA(1, 0, At, B0); PG8_MMA(1, 1, At, B1); PG8_BAR; PG8_SCHED;
            PG8_LDB(B0, 1, 0); PG8_LDB(B1, 1, 1); PG8_SCHED; PG8_LDA(At, 1, 0); PG8_STAGE(PG8_SA(0, 1), a2 + hstep, voffA);
            PG8_WAIT_V(8); PG8_WAIT_L(0); PG8_BAR; PG8_MMA(0, 0, At, B0); PG8_MMA(0, 1, At, B1); PG8_BAR; PG8_SCHED;
            PG8_LDA(At, 1, 1); PG8_STAGE(PG8_SB(1, 0), b3, voffB); PG8_STAGE(PG8_SB(1, 1), b3 + hstep, voffB); PG8_STAGE(PG8_SA(1, 0), a3, voffA);
            PG8_WAIT_V(8); PG8_WAIT_L(0); PG8_BAR; PG8_MMA(1, 0, At, B0); PG8_MMA(1, 1, At, B1); PG8_BAR; PG8_SCHED;
        }
        if (wr == 0) PG8_BAR;
        E(acc, cur, wr, wc, fr, fq);
        if (!has_next) break;
#pragma unroll
        for (int a = 0; a < 2; ++a)
#pragma unroll
            for (int b = 0; b < 2; ++b)
#pragma unroll
                for (int m = 0; m < 4; ++m)
#pragma unroll
                    for (int n = 0; n < 2; ++n) acc[a][b][m][n] = (f32x4){0.f, 0.f, 0.f, 0.f};
        cur = nxt; cA = nA; cB = nB; ++ui;
        if (wr == 1) PG8_BAR;
    }
    PG8_WAIT_V(0);
    PG8_BAR;
#undef PG8_SA
#undef PG8_SB
#undef PG8_STAGE
#undef PG8_LDA
#undef PG8_LDB
#undef PG8_MMA
#undef PG8_WAIT_V
#undef PG8_WAIT_L
#undef PG8_BAR
#undef PG8_SCHED
}

struct EpiGU {
    static constexpr bool PERM = true;
    bf16_t* H; const float* ss;
    DI void operator()(const f32x4 (&acc)[2][2][4][2], const Unit& u, int wr, int wc, int fr, int fq) const {
        const int row0 = u.pm * BM + wr * 64 + fr, col0 = u.pn * 128 + wc * 32 + 8 * fq;
#pragma unroll
        for (int ai = 0; ai < 2; ++ai)
#pragma unroll
            for (int m = 0; m < 4; ++m) {
                const int row = row0 + ai * HALF + m * 16;
                const float r = rowscale(((const GAS float*)ss)[row]);
                float h[8];
#pragma unroll
                for (int n = 0; n < 2; ++n)
#pragma unroll
                    for (int j = 0; j < 4; ++j) {
                        const float g = acc[ai][0][m][n][j] * r, up = acc[ai][1][m][n][j] * r;
                        h[n * 4 + j] = g * frcp(1.0f + fexp2(-g * LOG2E)) * up;
                    }
                u32x4 w; w.x = cvt_pk_bf16(h[0], h[1]); w.y = cvt_pk_bf16(h[2], h[3]); w.z = cvt_pk_bf16(h[4], h[5]); w.w = cvt_pk_bf16(h[6], h[7]);
                *(GAS u32x4*)(H + (size_t)row * 5632 + col0) = w;
            }
    }
};
struct EpiRes {
    static constexpr bool PERM = true;
    const float* src; float* dst; bf16_t* xb; float* ss; float alpha;
    DI void operator()(const f32x4 (&acc)[2][2][4][2], const Unit& u, int wr, int wc, int fr, int fq) const {
        const int row0 = u.pm * BM + wr * 64 + fr, col0 = u.pn * BM + wc * 32 + 8 * fq;
#pragma unroll
        for (int ai = 0; ai < 2; ++ai)
#pragma unroll
            for (int m = 0; m < 4; ++m) {
                const int row = row0 + ai * HALF + m * 16; float sq = 0.f;
#pragma unroll
                for (int bj = 0; bj < 2; ++bj) {
                    const size_t off = (size_t)row * 2048 + col0 + bj * HALF;
                    const f32x4 x0 = *(const GAS f32x4*)(src + off), x1 = *(const GAS f32x4*)(src + off + 4);
                    const f32x4 y0 = x0 + alpha * acc[ai][bj][m][0], y1 = x1 + alpha * acc[ai][bj][m][1];
                    *(GAS f32x4*)(dst + off) = y0; *(GAS f32x4*)(dst + off + 4) = y1;
                    u32x4 w; w.x = cvt_pk_bf16(y0[0], y0[1]); w.y = cvt_pk_bf16(y0[2], y0[3]); w.z = cvt_pk_bf16(y1[0], y1[1]); w.w = cvt_pk_bf16(y1[2], y1[3]);
                    *(GAS u32x4*)(xb + off) = w;
                    sq += (y0[0] * y0[0] + y0[1] * y0[1]) + (y0[2] * y0[2] + y0[3] * y0[3]) + (y1[0] * y1[0] + y1[1] * y1[1]) + (y1[2] * y1[2] + y1[3] * y1[3]);
                }
                sq += __shfl_xor(sq, 16); sq += __shfl_xor(sq, 32);
                if (fq == 0) __builtin_amdgcn_global_atomic_fadd_f32((GAS float*)(ss + row), sq);
            }
    }
};
struct EpiQK {
    static constexpr bool PERM = true;
    bf16_t* QK; const float* ss; const float* cs; const float* sn; int rope;
    DI void operator()(const f32x4 (&acc)[2][2][4][2], const Unit& u, int wr, int wc, int fr, int fq) const {
        const int row0 = u.pm * BM + wr * 64 + fr, col0 = u.pn * BM + wc * 32 + 8 * fq;
        const bool rot = rope && (wc == 0);
#pragma unroll
        for (int ai = 0; ai < 2; ++ai)
#pragma unroll
            for (int m = 0; m < 4; ++m) {
                const int row = row0 + ai * HALF + m * 16;
                const float r = rowscale(((const GAS float*)ss)[row]);
                f32x4 c4 = (f32x4){1.f, 1.f, 1.f, 1.f}, s4 = (f32x4){0.f, 0.f, 0.f, 0.f};
                if (rot) { const int pos = row & 2047; c4 = *(const GAS f32x4*)(cs + pos * 16 + 4 * fq); s4 = *(const GAS f32x4*)(sn + pos * 16 + 4 * fq); }
#pragma unroll
                for (int bj = 0; bj < 2; ++bj) {
                    f32x4 v0 = acc[ai][bj][m][0] * r, v1 = acc[ai][bj][m][1] * r;
                    const f32x4 n0 = v0 * c4 - v1 * s4, n1 = v1 * c4 + v0 * s4;
                    u32x4 w; w.x = cvt_pk_bf16(n0[0], n0[1]); w.y = cvt_pk_bf16(n0[2], n0[3]); w.z = cvt_pk_bf16(n1[0], n1[1]); w.w = cvt_pk_bf16(n1[2], n1[3]);
                    *(GAS u32x4*)(QK + (size_t)row * 4096 + col0 + bj * HALF) = w;
                }
            }
    }
};
struct EpiVT {
    static constexpr bool PERM = false;
    bf16_t* VT; const float* ss;
    DI void operator()(const f32x4 (&acc)[2][2][4][2], const Unit& u, int wr, int wc, int fr, int fq) const {
        const int colb = u.pn * BM + wc * 32 + fr;
#pragma unroll
        for (int ai = 0; ai < 2; ++ai)
#pragma unroll
            for (int mp = 0; mp < 2; ++mp) {
                const int tokb = u.pm * BM + ai * HALF + wr * 64;
                const int tokA = tokb + (2 * mp) * 16 + 4 * fq, tokB = tokA + 16;
                const f32x4 sa = *(const GAS f32x4*)(ss + tokA), sb = *(const GAS f32x4*)(ss + tokB);
                f32x4 rA, rB;
#pragma unroll
                for (int j = 0; j < 4; ++j) { rA[j] = rowscale(sa[j]); rB[j] = rowscale(sb[j]); }
                const int b = tokb >> 11, pos = (tokb & 2047) + 32 * mp + 8 * fq;
#pragma unroll
                for (int bj = 0; bj < 2; ++bj)
#pragma unroll
                    for (int n = 0; n < 2; ++n) {
                        const int col = colb + bj * HALF + n * 16, hh = col >> 7, d = col & 127;
                        const f32x4 vA = acc[ai][bj][2 * mp][n] * rA, vB = acc[ai][bj][2 * mp + 1][n] * rB;
                        u32x4 w; w.x = cvt_pk_bf16(vA[0], vA[1]); w.y = cvt_pk_bf16(vA[2], vA[3]); w.z = cvt_pk_bf16(vB[0], vB[1]); w.w = cvt_pk_bf16(vB[2], vB[3]);
                        *(GAS u32x4*)(VT + ((size_t)((b * 16 + hh) * 128 + d)) * 2048 + pos) = w;
                    }
            }
    }
};
}

DI int rope_dim_of_pos(int p) { return ((p & 7) < 4) ? (4 * (p >> 3) + (p & 3)) : (16 + 4 * (p >> 3) + (p & 3)); }

DI void convert_item(const float* W, int ldw, int colbase, bool perm, const float* g, bf16_t* WT, int K, int drow0, int kb, LAS float* scr, int lane) {
    const int k0 = 64 * kb, i31 = lane & 31;
    const int srccol = colbase + (perm ? rope_dim_of_pos(i31) : i31);
#pragma unroll 8
    for (int i = 0; i < 32; ++i) { const int kk = 2 * i + (lane >> 5); float v = ((const GAS float*)W)[(size_t)(k0 + kk) * ldw + srccol]; if (g) v *= ((const GAS float*)g)[k0 + kk]; scr[kk * 33 + i31] = v; }
    asm volatile("s_waitcnt lgkmcnt(0)" ::: "memory");
    const int c = lane & 7;
#pragma unroll
    for (int j = 0; j < 4; ++j) { const int n = (lane >> 3) + 8 * j; const LAS float* s = scr + (8 * c) * 33 + n;
        u32x4 o; o.x = cvt_pk_bf16(s[0 * 33], s[1 * 33]); o.y = cvt_pk_bf16(s[2 * 33], s[3 * 33]); o.z = cvt_pk_bf16(s[4 * 33], s[5 * 33]); o.w = cvt_pk_bf16(s[6 * 33], s[7 * 33]);
        *(GAS u32x4*)(WT + (size_t)(drow0 + n) * K + k0 + 8 * c) = o; }
    asm volatile("s_waitcnt lgkmcnt(0)" ::: "memory");
}

DI void phase0(const Params& p, LAS unsigned char* lds) {
    const int tid = phase_tid(), lane = tid & 63, wave = tid >> 6;
    const int gw = blockIdx.x * 8 + wave, NGW = gridDim.x * 8;
    LAS float* scr = (LAS float*)(lds + wave * 8448);
    constexpr int I_GU = 32 * 352, I_D = 88 * 64, I_QKV = 32 * 192, I_OUT = 32 * 64;
    constexpr int NIT = 4 * I_GU + 4 * I_D + 2 * I_QKV + 2 * I_OUT;
    for (int it = gw; it < NIT; it += NGW) {
        int r = it; const float* W; int ldw, colbase, K, drow0, kb; const float* g = nullptr; bf16_t* WT; bool perm = false;
        if (r < 4 * I_GU) {
            const int q = r / I_GU; r -= q * I_GU; const int layer = q >> 1, ffn = q & 1; kb = r / 352; const int nb = r % 352; drow0 = 32 * nb;
            const int tile = drow0 >> 8, within = drow0 & 255, bj = within >> 7, cc = within & 127;
            const float* gate = ffn ? p.f2g : p.f1g; const float* up = ffn ? p.f2u : p.f1u;
            W = (bj ? up : gate) + (size_t)layer * 2048 * 5632; ldw = 5632; colbase = 128 * tile + cc; K = 2048;
            g = p.norm_g + (layer * 3 + (ffn ? 2 : 0)) * 2048; WT = (bf16_t*)(p.ws + WS_WGU + (size_t)q * SZ_WGU);
        } else if ((r -= 4 * I_GU) < 4 * I_D) {
            const int q = r / I_D; r -= q * I_D; const int layer = q >> 1, ffn = q & 1; kb = r / 64; const int nb = r % 64; drow0 = 32 * nb;
            W = (ffn ? p.f2d : p.f1d) + (size_t)layer * 5632 * 2048; ldw = 2048; colbase = drow0; K = 5632; WT = (bf16_t*)(p.ws + WS_WD + (size_t)q * SZ_WD);
        } else if ((r -= 4 * I_D) < 2 * I_QKV) {
            const int layer = r / I_QKV; r -= layer * I_QKV; kb = r / 192; const int nb = r % 192; drow0 = 32 * nb;
            W = layer ? p.oqkv : p.ewin; ldw = layer ? 6144 : 6152; colbase = drow0; K = 2048; g = p.norm_g + (layer * 3 + 1) * 2048;
            perm = layer && nb < 128 && (nb & 3) == 0; WT = (bf16_t*)(p.ws + WS_WQKV + (size_t)layer * SZ_WQKV);
        } else {
            r -= 2 * I_QKV; const int layer = r / I_OUT; r -= layer * I_OUT; kb = r / 64; const int nb = r % 64; drow0 = 32 * nb;
            W = layer ? p.owout : p.ewout; ldw = 2048; colbase = drow0; K = 2048; WT = (bf16_t*)(p.ws + WS_WOUT + (size_t)layer * SZ_WOUT);
        }
        convert_item(W, ldw, colbase, perm, g, WT, K, drow0, kb, scr, lane);
    }
    {
        float* ss0 = (float*)(p.ws + WS_SS); bf16_t* xb = (bf16_t*)(p.ws + WS_XB);
        for (int row = gw; row < 16384; row += NGW) {
            const GAS f32x4* xr = (const GAS f32x4*)(p.x + (size_t)row * 2048) + lane;
            GAS u32x2* o = (GAS u32x2*)(xb + (size_t)row * 2048) + lane;
            float sq = 0.f;
#pragma unroll
            for (int j = 0; j < 8; ++j) { const f32x4 v = xr[64 * j]; sq += (v[0] * v[0] + v[1] * v[1]) + (v[2] * v[2] + v[3] * v[3]);
                u32x2 w; w.x = cvt_pk_bf16(v[0], v[1]); w.y = cvt_pk_bf16(v[2], v[3]); o[64 * j] = w; }
#pragma unroll
            for (int o2 = 1; o2 < 64; o2 <<= 1) sq += __shfl_xor(sq, o2);
            if (lane == 0) ((GAS float*)ss0)[row] = sq;
        }
    }
    const int gt = blockIdx.x * 512 + tid, NGT = gridDim.x * 512;
    { GAS float* ss = (GAS float*)(p.ws + WS_SS); for (int i = 16384 + gt; i < 7 * 16384; i += NGT) ss[i] = 0.f; }
    { GAS float* cs = (GAS float*)(p.ws + WS_COS); GAS float* sn = (GAS float*)(p.ws + WS_SIN);
      for (int i = gt; i < 2048 * 16; i += NGT) { const int pos = i >> 4, fi = i & 15; const float ang = (float)pos * p.freq[fi];
          double rev = (double)ang * 0.15915494309189535; rev -= floor(rev); const float fr = (float)rev;
          cs[i] = __builtin_amdgcn_cosf(fr); sn[i] = __builtin_amdgcn_sinf(fr); } }
    { GAS bf16_t* wf = (GAS bf16_t*)(p.ws + WS_WF); const GAS float* g1 = (const GAS float*)(p.norm_g + 1 * 2048);
      for (int i = gt; i < 8 * 2048; i += NGT) { const int j = i >> 11, k = i & 2047; const float v = ((const GAS float*)p.ewin)[(size_t)k * 6152 + 6144 + j] * g1[k];
          wf[i] = (bf16_t)(cvt_pk_bf16(v, 0.f) & 0xffffu); } }
}

DI float bf_lo(unsigned w) { return __uint_as_float(w << 16); }
DI float bf_hi(unsigned w) { return __uint_as_float(w & 0xffff0000u); }
DI void phase_fgate(const Params& p) {
    const int tid = phase_tid(), lane = tid & 63, wave = tid >> 6;
    const GAS bf16_t* xb = (const GAS bf16_t*)(p.ws + WS_XB); const GAS bf16_t* wf = (const GAS bf16_t*)(p.ws + WS_WF);
    const GAS float* ss1 = (const GAS float*)(p.ws + WS_SS) + 1 * 16384; GAS float* logf = (GAS float*)(p.ws + WS_LOGF);
    for (int row = blockIdx.x * 8 + wave; row < 16384; row += gridDim.x * 8) {
        float a[8];
#pragma unroll
        for (int j = 0; j < 8; ++j) a[j] = 0.f;
#pragma unroll
        for (int c = 0; c < 4; ++c) {
            const int k = 512 * c + 8 * lane;
            const u32x4 xv = *(const GAS u32x4*)(xb + (size_t)row * 2048 + k);
            const float x0 = bf_lo(xv.x), x1 = bf_hi(xv.x), x2 = bf_lo(xv.y), x3 = bf_hi(xv.y), x4 = bf_lo(xv.z), x5 = bf_hi(xv.z), x6 = bf_lo(xv.w), x7 = bf_hi(xv.w);
#pragma unroll
            for (int j = 0; j < 8; ++j) { const u32x4 wv = *(const GAS u32x4*)(wf + j * 2048 + k);
                a[j] += (x0 * bf_lo(wv.x) + x1 * bf_hi(wv.x)) + (x2 * bf_lo(wv.y) + x3 * bf_hi(wv.y)) + (x4 * bf_lo(wv.z) + x5 * bf_hi(wv.z)) + (x6 * bf_lo(wv.w) + x7 * bf_hi(wv.w)); }
        }
#pragma unroll
        for (int j = 0; j < 8; ++j) {
#pragma unroll
            for (int o = 1; o < 64; o <<= 1) a[j] += __shfl_xor(a[j], o);
        }
        if (lane < 8) {
            float v = a[0];
#pragma unroll
            for (int j = 1; j < 8; ++j) v = (lane == j) ? a[j] : v;
            v = v * rowscale(ss1[row]) + ((const GAS float*)p.ebf)[lane];
            const float ls = fminf(v, 0.f) - flog2(1.0f + fexp2(-fabsf(v) * LOG2E)) * LN2;
            const int b = row >> 11, s = row & 2047;
            logf[(size_t)(b * 8 + lane) * 2048 + s] = ls;
        }
    }
}

constexpr int KS_STRIDE = 272, VS_STRIDE = 144, VS_OFF = 64 * KS_STRIDE, CF_OFF = 36864, TMP_OFF = CF_OFF + 8192;
#define MFMA16(a, b, c) __builtin_amdgcn_mfma_f32_16x16x32_bf16((a), (b), (c), 0, 0, 0)

template <int MODE, int NCB>
DI void attn_qblock(LAS unsigned char* lds, const bf16_t* qk_, const bf16_t* vt_, bf16_t* ao_, int b, int head, int qb) {
    const int tid = phase_tid(), wid = __builtin_amdgcn_readfirstlane(tid >> 6), lane = tid & 63, c = lane & 15, q = lane >> 4;
    const int tq0 = qb * (128 * NCB) + 16 * NCB * wid;
    LAS unsigned char* Ks = lds; LAS unsigned char* Vs = lds + VS_OFF; const LAS float* cf = (const LAS float*)(lds + CF_OFF);
    const GAS bf16_t* qk = (const GAS bf16_t*)qk_; const GAS bf16_t* vt = (const GAS bf16_t*)vt_;
    bf16x8 qf[NCB][4];
#pragma unroll
    for (int cb = 0; cb < NCB; ++cb)
#pragma unroll
        for (int ks = 0; ks < 4; ++ks) qf[cb][ks] = *(const GAS bf16x8*)(qk + (size_t)(b * 2048 + tq0 + 16 * cb + c) * 4096 + head * 128 + 32 * ks + 8 * q);
    f32x4 o[8][NCB];
#pragma unroll
    for (int db = 0; db < 8; ++db)
#pragma unroll
        for (int cb = 0; cb < NCB; ++cb) o[db][cb] = (f32x4){0.f, 0.f, 0.f, 0.f};
    float st_m[2] = {-1e30f, -1e30f}, st_l[2] = {0.f, 0.f};
    float cfq[2] = {0.f, 0.f};
    if (MODE == 1) { cfq[0] = cf[tq0 + c]; if (NCB == 2) cfq[1] = cf[tq0 + 16 + c]; }
    bf16x8 T00, T10, T21, T31, TONE;
    if (MODE == 0) {
#pragma unroll
        for (int j = 0; j < 8; ++j) {
            const int kl = (j < 4) ? (4 * q + j) : (16 + 4 * q + (j - 4));
            T00[j] = (kl > c) ? (short)0x3F80 : (short)0;
            T10[j] = (kl > 16 + c) ? (short)0x3F80 : (short)0;
            T21[j] = (32 + kl > 32 + c) ? (short)0x3F80 : (short)0;
            T31[j] = (32 + kl > 48 + c) ? (short)0x3F80 : (short)0;
            TONE[j] = (short)0x3F80;
        }
    }
    const int nkt = 2 * NCB * (qb + 1);
    const GAS bf16_t* kbase = qk + (size_t)(b * 2048) * 4096 + 2048 + head * 128;
    const GAS bf16_t* vbase = vt + (size_t)((b * 16 + head) * 128) * 2048;
    const int krow0 = tid >> 4, kc16 = tid & 15, vd0 = tid >> 3, vc8 = tid & 7;
    u32x4 kr[2], vr[2];
#define ATT_ISSUE(kt_) do { const int k0_ = (kt_) * 64; _Pragma("unroll") for (int i_ = 0; i_ < 2; ++i_) { \
        kr[i_] = *(const GAS u32x4*)(kbase + (size_t)(k0_ + krow0 + 32 * i_) * 4096 + 8 * kc16); \
        vr[i_] = *(const GAS u32x4*)(vbase + (size_t)(vd0 + 64 * i_) * 2048 + k0_ + 8 * vc8); } } while (0)
    ATT_ISSUE(nkt - 1);
    for (int kt = nkt - 1; kt >= 0; --kt) {
        __syncthreads();
#pragma unroll
        for (int i = 0; i < 2; ++i) { *(LAS u32x4*)(Ks + (krow0 + 32 * i) * KS_STRIDE + 16 * kc16) = kr[i]; *(LAS u32x4*)(Vs + (vd0 + 64 * i) * VS_STRIDE + 16 * vc8) = vr[i]; }
        __syncthreads();
        if (kt > 0) ATT_ISSUE(kt - 1);
        const int k0 = kt * 64;
        if (k0 <= tq0 + 16 * NCB - 1) {
            f32x4 s[4][NCB];
#pragma unroll
            for (int rb = 0; rb < 4; ++rb)
#pragma unroll
                for (int cb = 0; cb < NCB; ++cb) s[rb][cb] = (f32x4){0.f, 0.f, 0.f, 0.f};
#pragma unroll
            for (int ks = 0; ks < 4; ++ks)
#pragma unroll
                for (int rb = 0; rb < 4; ++rb) {
                    const bf16x8 kf = *(const LAS bf16x8*)(Ks + (16 * rb + c) * KS_STRIDE + (32 * ks + 8 * q) * 2);
#pragma unroll
                    for (int cb = 0; cb < NCB; ++cb) s[rb][cb] = MFMA16(kf, qf[cb][ks], s[rb][cb]);
                }
            bf16x8 pf[NCB][2];
#pragma unroll
            for (int cb = 0; cb < NCB; ++cb) {
                const int t = tq0 + 16 * cb + c;
                if (MODE == 0) {
                    float sp[4][4]; float tot = 0.f;
#pragma unroll
                    for (int rb = 0; rb < 4; ++rb)
#pragma unroll
                        for (int j = 0; j < 4; ++j) {
                            const int kidx = k0 + 16 * rb + 4 * q + j;
                            const float z = s[rb][cb][j] * SCALE;
                            float v = fmaxf(z, 0.f) + flog2(1.0f + fexp2(-fabsf(z) * LOG2E)) * LN2;
                            v = (kidx < t) ? v : 0.f;
                            sp[rb][j] = v; tot += v; s[rb][cb][j] = z - v;
                        }
                    tot += __shfl_xor(tot, 16); tot += __shfl_xor(tot, 32);
                    bf16x8 sph[2], spl[2];
#pragma unroll
                    for (int g = 0; g < 2; ++g) {
                        u32x4 hh, ll;
#pragma unroll
                        for (int e = 0; e < 4; ++e) {
                            const int rb = 2 * g + (e >> 1), j0 = 2 * (e & 1);
                            const unsigned hb = cvt_pk_bf16(sp[rb][j0], sp[rb][j0 + 1]);
                            hh[e] = hb; ll[e] = cvt_pk_bf16(sp[rb][j0] - bf_lo(hb), sp[rb][j0 + 1] - bf_hi(hb));
                        }
                        sph[g] = __builtin_bit_cast(bf16x8, hh); spl[g] = __builtin_bit_cast(bf16x8, ll);
                    }
                    f32x4 a[4];
#pragma unroll
                    for (int rs = 0; rs < 4; ++rs) a[rs] = (f32x4){0.f, 0.f, 0.f, 0.f};
                    a[0] = MFMA16(T00, sph[0], a[0]); a[0] = MFMA16(T00, spl[0], a[0]); a[0] = MFMA16(TONE, sph[1], a[0]); a[0] = MFMA16(TONE, spl[1], a[0]);
                    a[1] = MFMA16(T10, sph[0], a[1]); a[1] = MFMA16(T10, spl[0], a[1]); a[1] = MFMA16(TONE, sph[1], a[1]); a[1] = MFMA16(TONE, spl[1], a[1]);
                    a[2] = MFMA16(T21, sph[1], a[2]); a[2] = MFMA16(T21, spl[1], a[2]);
                    a[3] = MFMA16(T31, sph[1], a[3]); a[3] = MFMA16(T31, spl[1], a[3]);
                    const float carry = st_l[cb];
#pragma unroll
                    for (int rb = 0; rb < 4; ++rb)
#pragma unroll
                        for (int j = 0; j < 4; ++j) {
                            const int kidx = k0 + 16 * rb + 4 * q + j;
                            const float w = fexp2((s[rb][cb][j] - a[rb][j] - carry) * LOG2E);
                            s[rb][cb][j] = (kidx < t) ? w : 0.f;
                        }
                    st_l[cb] = carry + tot;
                } else {
                    float mx = -1e30f;
#pragma unroll
                    for (int rb = 0; rb < 4; ++rb) {
                        f32x4 ck = (f32x4){0.f, 0.f, 0.f, 0.f};
                        if (MODE == 1) ck = *(const LAS f32x4*)(cf + k0 + 16 * rb + 4 * q);
#pragma unroll
                        for (int j = 0; j < 4; ++j) {
                            const int kidx = k0 + 16 * rb + 4 * q + j;
                            float z;
                            if (MODE == 1) { z = (s[rb][cb][j] * SCALE + (cfq[cb] - ck[j])) * LOG2E; z = (kidx <= t) ? z : -1e30f; }
                            else { const int dist = t - kidx; const bool valid = (dist >= 0) && ((dist <= 128) || (((dist & 3) == 0) && (dist <= 512)) || ((dist & 15) == 0));
                                   z = valid ? s[rb][cb][j] * (SCALE * LOG2E) : -1e30f; }
                            s[rb][cb][j] = z; mx = fmaxf(mx, z);
                        }
                    }
                    mx = fmaxf(mx, __shfl_xor(mx, 16)); mx = fmaxf(mx, __shfl_xor(mx, 32));
                    const float mnew = fmaxf(st_m[cb], mx), alpha = fexp2(st_m[cb] - mnew); st_m[cb] = mnew;
                    float sum = 0.f;
#pragma unroll
                    for (int rb = 0; rb < 4; ++rb)
#pragma unroll
                        for (int j = 0; j < 4; ++j) {
                            float pv = fexp2(s[rb][cb][j] - mnew);
                            if (MODE == 2) { const int dist = t - (k0 + 16 * rb + 4 * q + j);
                                const float mult = (dist >= 0) ? ((dist <= 128 ? 1.f : 0.f) + ((((dist & 3) == 0) && (dist <= 512)) ? 1.f : 0.f) + (((dist & 15) == 0) ? 1.f : 0.f)) : 0.f;
                                pv *= mult; }
                            s[rb][cb][j] = pv; sum += pv;
                        }
                    sum += __shfl_xor(sum, 16); sum += __shfl_xor(sum, 32);
                    st_l[cb] = st_l[cb] * alpha + sum;
#pragma unroll
                    for (int db = 0; db < 8; ++db) o[db][cb] *= alpha;
                }
#pragma unroll
                for (int g = 0; g < 2; ++g) {
                    u32x4 w; w.x = cvt_pk_bf16(s[2 * g][cb][0], s[2 * g][cb][1]); w.y = cvt_pk_bf16(s[2 * g][cb][2], s[2 * g][cb][3]);
                    w.z = cvt_pk_bf16(s[2 * g + 1][cb][0], s[2 * g + 1][cb][1]); w.w = cvt_pk_bf16(s[2 * g + 1][cb][2], s[2 * g + 1][cb][3]);
                    pf[cb][g] = __builtin_bit_cast(bf16x8, w);
                }
            }
#pragma unroll
            for (int db = 0; db < 8; ++db)
#pragma unroll
                for (int g = 0; g < 2; ++g) {
                    const bf16x8 vf = *(const LAS bf16x8*)(Vs + (16 * db + c) * VS_STRIDE + (32 * g + 8 * q) * 2);
#pragma unroll
                    for (int cb = 0; cb < NCB; ++cb) o[db][cb] = MFMA16(vf, pf[cb][g], o[db][cb]);
                }
        }
    }
#undef ATT_ISSUE
    GAS bf16_t* ao = (GAS bf16_t*)ao_;
#pragma unroll
    for (int cb = 0; cb < NCB; ++cb) {
        const float inv = (MODE == 0) ? 1.0f : frcp(st_l[cb]);
        GAS bf16_t* orow = ao + (size_t)(b * 2048 + tq0 + 16 * cb + c) * 2048 + head * 128 + 4 * q;
#pragma unroll
        for (int db = 0; db < 8; ++db) { const f32x4 v = o[db][cb] * inv; u32x2 w; w.x = cvt_pk_bf16(v[0], v[1]); w.y = cvt_pk_bf16(v[2], v[3]); *(GAS u32x2*)(orow + 16 * db) = w; }
    }
}

DI void fox_cumsum(const float* lf_, LAS unsigned char* lds) {
    const int tid = phase_tid(), lane = tid & 63, wave = tid >> 6;
    LAS float* cf = (LAS float*)(lds + CF_OFF); LAS float* tmp = (LAS float*)(lds + TMP_OFF);
    __syncthreads();
    f32x4 v = *(const GAS f32x4*)((const GAS float*)lf_ + 4 * tid);
    v[1] += v[0]; v[2] += v[1]; v[3] += v[2];
    const float tot = v[3]; float sc = tot;
#pragma unroll
    for (int o = 1; o < 64; o <<= 1) { const float t = __shfl_up(sc, o); if (lane >= o) sc += t; }
    if (lane == 63) tmp[wave] = sc;
    __syncthreads();
    float base = sc - tot;
    for (int w = 0; w < wave; ++w) base += tmp[w];
    v += base; *(LAS f32x4*)(cf + 4 * tid) = v;
    __syncthreads();
}

DI void phase_attn_even(const Params& p, LAS unsigned char* lds) {
    const bf16_t* qk = (const bf16_t*)(p.ws + WS_BIG); const bf16_t* vt = (const bf16_t*)(p.ws + WS_VT); bf16_t* ao = (bf16_t*)(p.ws + WS_AO);
    for (int pr = blockIdx.x; pr < 768; pr += gridDim.x) {
        if (pr < 512) {
            const int bh = pr >> 3, pi = pr & 7, b = bh >> 3, hh = bh & 7;
            if (ATT_PARTS & 1) for (int half = 0; half < 2; ++half) attn_qblock<0, 1>(lds, qk, vt, ao, b, hh, half ? pi : 15 - pi);
        } else {
            const int pp = pr - 512, bh = pp >> 2, pi = pp & 3, b = bh >> 3, hh = bh & 7;
            fox_cumsum((const float*)(p.ws + WS_LOGF) + (size_t)(b * 8 + hh) * 2048, lds);
            if (ATT_PARTS & 2) for (int half = 0; half < 2; ++half) attn_qblock<1, 2>(lds, qk, vt, ao, b, 8 + hh, half ? pi : 7 - pi);
        }
    }
}
DI void phase_attn_odd(const Params& p, LAS unsigned char* lds) {
    const bf16_t* qk = (const bf16_t*)(p.ws + WS_BIG); const bf16_t* vt = (const bf16_t*)(p.ws + WS_VT); bf16_t* ao = (bf16_t*)(p.ws + WS_AO);
    for (int pr = blockIdx.x; pr < 512; pr += gridDim.x) {
        const int bh = pr >> 2, pi = pr & 3, b = bh >> 4, h = bh & 15;
        for (int half = 0; half < 2; ++half) attn_qblock<2, 2>(lds, qk, vt, ao, b, h, half ? pi : 7 - pi);
    }
}

DI void phase_final(const Params& p) {
    const int tid = phase_tid(), lane = tid & 63, wave = tid >> 6;
    const GAS float* ss6 = (const GAS float*)(p.ws + WS_SS) + 6 * 16384;
    for (int row = blockIdx.x * 8 + wave; row < 16384; row += gridDim.x * 8) {
        const float r = rowscale(ss6[row]);
        GAS f32x4* xr = (GAS f32x4*)(p.out + (size_t)row * 2048) + lane; const GAS f32x4* gr = (const GAS f32x4*)p.fng + lane;
#pragma unroll
        for (int j = 0; j < 8; ++j) { const f32x4 v = xr[64 * j]; xr[64 * j] = v * r * gr[64 * j]; }
    }
}

__global__ void __launch_bounds__(512) mega(Params p) {
    extern __shared__ __attribute__((aligned(16))) unsigned char smem[];
    LAS unsigned char* lds = (LAS unsigned char*)smem;
    cg::grid_group grid = cg::this_grid();
    bf16_t* xb = (bf16_t*)(p.ws + WS_XB); bf16_t* ao = (bf16_t*)(p.ws + WS_AO); bf16_t* hid = (bf16_t*)(p.ws + WS_BIG);
    bf16_t* qk = (bf16_t*)(p.ws + WS_BIG); bf16_t* vt = (bf16_t*)(p.ws + WS_VT); float* ss = (float*)(p.ws + WS_SS);
    for (int ph = p.ph_lo; ph < p.ph_hi; ++ph) {
        if (ph > p.ph_lo) grid.sync();
        if (EN_P0 && ph == 0) { phase0(p, lds); }
        else if (EN_FIN && ph == 15) { phase_final(p); }
        else {
            const int layer = (ph - 1) / 7, sub = (ph - 1) % 7;
            if (EN_GU && (sub == 0 || sub == 5)) {
                const int ffn = sub == 5, q = layer * 2 + ffn, ni = layer * 3 + (ffn ? 2 : 0);
                pg8::EpiGU E{hid, ss + ni * 16384};
                pg8::gemm_phase<pg8::EpiGU, false>(lds, xb, (const bf16_t*)(p.ws + WS_WGU + (size_t)q * SZ_WGU), 16384, 11264, 2048, E);
            } else if (EN_RES && (sub == 1 || sub == 6 || sub == 4)) {
                const int ffn = sub == 6; const bool isout = sub == 4;
                const int q = layer * 2 + ffn; const int ni = layer * 3 + (isout ? 2 : (ffn ? 3 : 1));
                const float* src = (layer == 0 && sub == 1) ? p.x : p.out;
                pg8::EpiRes E{src, p.out, xb, ss + ni * 16384, isout ? 1.0f : 0.5f};
                const bf16_t* A = isout ? ao : hid; const bf16_t* Bt = isout ? (const bf16_t*)(p.ws + WS_WOUT + (size_t)layer * SZ_WOUT) : (const bf16_t*)(p.ws + WS_WD + (size_t)q * SZ_WD);
                pg8::gemm_phase<pg8::EpiRes, false>(lds, A, Bt, 16384, 2048, isout ? 2048 : 5632, E);
            } else if (EN_QKV && sub == 2) {
                const int ni = layer * 3 + 1; const bf16_t* W = (const bf16_t*)(p.ws + WS_WQKV + (size_t)layer * SZ_WQKV);
                pg8::EpiQK E{qk, ss + ni * 16384, (const float*)(p.ws + WS_COS), (const float*)(p.ws + WS_SIN), layer};
                if (QKV_PARTS & 1) pg8::gemm_phase<pg8::EpiQK, false>(lds, xb, W, 16384, 4096, 2048, E);
                pg8::EpiVT E2{vt, ss + ni * 16384};
                if (QKV_PARTS & 2) pg8::gemm_phase<pg8::EpiVT, true>(lds, xb, W + (size_t)4096 * 2048, 16384, 2048, 2048, E2);
                if ((QKV_PARTS & 4) && layer == 0) phase_fgate(p);
            } else if (sub == 3) {
                if (EN_ATT0 && layer == 0) phase_attn_even(p, lds); else if (EN_ATT1 && layer == 1) phase_attn_odd(p, lds);
            }
        }
    }
}

extern "C" void kernel_launch(void* const* d_in, const int* in_sizes, int n_in, void* d_out, int out_size, void* d_ws, size_t ws_size, hipStream_t stream) {
    static int grid_blocks = 0;
    if (grid_blocks == 0) {
        if (n_in != 14 || ws_size < WS_END) { fprintf(stderr, "kernel_launch: unexpected n_in %d or ws_size %zu (< %zu)\n", n_in, ws_size, (size_t)WS_END); grid_blocks = -1; return; }
        int dev = 0, cus = 0, per_cu = 0;
        hipGetDevice(&dev);
        hipDeviceGetAttribute(&cus, hipDeviceAttributeMultiprocessorCount, dev);
        if (hipFuncSetAttribute((const void*)mega, hipFuncAttributeMaxDynamicSharedMemorySize, LDS_BYTES) != hipSuccess) { fprintf(stderr, "kernel_launch: hipFuncSetAttribute failed\n"); grid_blocks = -1; return; }
        if (hipOccupancyMaxActiveBlocksPerMultiprocessor(&per_cu, (const void*)mega, 512, LDS_BYTES) != hipSuccess || per_cu < 1) { fprintf(stderr, "kernel_launch: occupancy query failed (%d)\n", per_cu); per_cu = 1; (void)hipGetLastError(); }
        grid_blocks = cus * per_cu;
    }
    if (grid_blocks < 0) return;
    Params p; memset(&p, 0, sizeof(p));
    p.x = (const float*)d_in[0]; p.norm_g = (const float*)d_in[1];
    p.f1g = (const float*)d_in[2]; p.f1u = (const float*)d_in[3]; p.f1d = (const float*)d_in[4];
    p.f2g = (const float*)d_in[5]; p.f2u = (const float*)d_in[6]; p.f2d = (const float*)d_in[7];
    p.ewin = (const float*)d_in[8]; p.ebf = (const float*)d_in[9]; p.ewout = (const float*)d_in[10];
    p.oqkv = (const float*)d_in[11]; p.owout = (const float*)d_in[12]; p.fng = (const float*)d_in[13];
    p.out = (float*)d_out; p.ws = (unsigned char*)d_ws;
    for (int i = 0; i < 16; ++i) p.freq[i] = (float)pow(500000.0, -(double)i / 16.0);
#if MK_SINGLE
    p.ph_lo = 0; p.ph_hi = 16;
    void* args[] = {&p};
    hipError_t e = hipLaunchCooperativeKernel((void*)mega, dim3(grid_blocks), dim3(512), args, LDS_BYTES, stream);
    if (e != hipSuccess) fprintf(stderr, "cooperative launch failed: %s (grid %d)\n", hipGetErrorString(e), grid_blocks);
#else
    for (int ph = 0; ph < 16; ++ph) {
        p.ph_lo = ph; p.ph_hi = ph + 1;
        hipLaunchKernelGGL(mega, dim3(grid_blocks), dim3(512), LDS_BYTES, stream, p);
    }
#endif
}
```

```cpp
#include <hip/hip_runtime.h>
#include <hip/hip_cooperative_groups.h>
#include <cstdio>
#include <cstring>
#include <cmath>
namespace cg = cooperative_groups;

#ifndef MK_SINGLE
#define MK_SINGLE 1
#endif

#ifndef EN_P0
#define EN_P0 1
#endif
#ifndef EN_FIN
#define EN_FIN 1
#endif
#ifndef EN_GU
#define EN_GU 1
#endif
#ifndef EN_RES
#define EN_RES 1
#endif
#ifndef EN_QKV
#define EN_QKV 1
#endif
#ifndef EN_ATT0
#define EN_ATT0 1
#endif
#ifndef EN_ATT1
#define EN_ATT1 1
#endif
#ifndef QKV_PARTS
#define QKV_PARTS 7
#endif
#ifndef ATT_PARTS
#define ATT_PARTS 3
#endif
#ifndef REPEAT_MASK
#define REPEAT_MASK 0
#endif
#ifndef PROBE_A
#define PROBE_A -1
#endif
#ifndef PROBE_A1
#define PROBE_A1 (PROBE_A + 1)
#endif
#ifndef PROBE_B
#define PROBE_B 0
#endif
#ifndef PROBE_B1
#define PROBE_B1 (PROBE_B + 1)
#endif
#define LAS __attribute__((address_space(3)))
#define GAS __attribute__((address_space(1)))
#define DI __device__ __forceinline__

typedef unsigned short bf16_t;
typedef short bf16x8 __attribute__((ext_vector_type(8)));
typedef float f32x4 __attribute__((ext_vector_type(4)));
typedef unsigned u32x4 __attribute__((ext_vector_type(4)));
typedef unsigned u32x2 __attribute__((ext_vector_type(2)));
typedef float f32x2 __attribute__((ext_vector_type(2)));

constexpr float EPS = 1e-6f, LOG2E = 1.4426950408889634f, LN2 = 0.6931471805599453f, SCALE = 0.08838834764831845f;
constexpr int LDS_BYTES = 131072;

constexpr size_t WS_SS = 0;
constexpr size_t WS_LOGF = 0x100000;
constexpr size_t WS_COS = 0x180000;
constexpr size_t WS_SIN = 0x1A0000;
constexpr size_t WS_WF = 0x1C0000;
constexpr size_t WS_WGU = 0x200000;
constexpr size_t SZ_WGU = (size_t)11264 * 2048 * 2;
constexpr size_t WS_WD = WS_WGU + 4 * SZ_WGU;
constexpr size_t SZ_WD = (size_t)2048 * 5632 * 2;
constexpr size_t WS_WQKV = WS_WD + 4 * SZ_WD;
constexpr size_t SZ_WQKV = (size_t)6144 * 2048 * 2;
constexpr size_t WS_WOUT = WS_WQKV + 2 * SZ_WQKV;
constexpr size_t SZ_WOUT = (size_t)2048 * 2048 * 2;
constexpr size_t WS_XB = WS_WOUT + 2 * SZ_WOUT;
constexpr size_t SZ_ACT = (size_t)16384 * 2048 * 2;
constexpr size_t WS_AO = WS_XB + SZ_ACT;
constexpr size_t WS_BIG = WS_AO + SZ_ACT;
constexpr size_t WS_VT = WS_BIG + (size_t)16384 * 4096 * 2;
constexpr size_t WS_END = WS_BIG + (size_t)16384 * 6144 * 2;

struct Params {
    const float* x; const float* norm_g;
    const float* f1g; const float* f1u; const float* f1d;
    const float* f2g; const float* f2u; const float* f2d;
    const float* ewin; const float* ebf; const float* ewout;
    const float* oqkv; const float* owout; const float* fng;
    float* out; unsigned char* ws;
    float freq[16];
    int ph_lo, ph_hi;
};

typedef float f32x2c __attribute__((ext_vector_type(2)));
typedef __bf16 bf16x2c __attribute__((ext_vector_type(2)));
DI unsigned cvt_pk_bf16(float lo, float hi) { const bf16x2c v = __builtin_convertvector((f32x2c){lo, hi}, bf16x2c); return __builtin_bit_cast(unsigned, v); }
DI int lane_id() { return (int)__builtin_amdgcn_mbcnt_hi(~0u, __builtin_amdgcn_mbcnt_lo(~0u, 0u)); }
DI int phase_tid(int wid_s) { int t = ((wid_s & 7) << 6) | lane_id(); asm volatile("" : "+v"(t)); return t; }
DI int lndi(int v) { asm volatile("" : "+s"(v)); return v; }
template <class T> DI T* lnd(T* p) { asm volatile("" : "+s"(p)); return p; }
DI float fexp2(float x) { return __builtin_amdgcn_exp2f(x); }
DI float flog2(float x) { return __builtin_amdgcn_logf(x); }
DI float frcp(float x) { return __builtin_amdgcn_rcpf(x); }
typedef unsigned long long u64;
DI float rowscale(u64 ss) { const float f = (float)(unsigned)(ss >> 32) * 4294967296.0f + (float)(unsigned)ss; return __builtin_amdgcn_rsqf(f * (1.0f / (2048.0f * 1048576.0f)) + EPS); }
DI u64 ss_fix(float sq) { return (u64)(sq * 1048576.0f); }

namespace pg8 {
constexpr int BM = 256, BK = 64, HALF = 128, HTB = HALF * BK * 2, STAGE_BYTES = 8 * HTB, NXCD = 8, WGM = 8;
__host__ __device__ __forceinline__ int lds_byte(int r, int c) { const int st = (r >> 4) * 2 + (c >> 5), rr = r & 15, cc = c & 31, ob = rr * 64 + cc * 2; return st * 1024 + (ob ^ (((ob >> 9) & 1) << 5)); }
__host__ __device__ __forceinline__ void stage_rc(int b, int& R, int& C) { const int st = b / 1024, sb = b % 1024, swz = sb ^ (((sb >> 9) & 1) << 5); R = (st >> 1) * 16 + swz / 64; C = (st & 1) * 32 + (swz % 64) / 2; }
__host__ __device__ __forceinline__ int perm32(int rho) { const int n = rho >> 4, i = rho & 15; return 8 * (i >> 2) + 4 * n + (i & 3); }
struct Unit { int pm, pn; };
struct StaticOrder {
    int nM, nN, nwg, G, c;
    __device__ void init(int M, int N, int G_, int c_) { nM = M / BM; nN = N / BM; nwg = nM * nN; G = G_; c = c_; }
    __device__ bool next(int i, Unit& u) const {
        const long L = (long)i * G + c; if (L >= nwg) return false;
        int wgid = (int)L; { const int q = nwg / NXCD, r = nwg % NXCD, xcd = wgid % NXCD, off = wgid / NXCD; wgid = (xcd < r ? xcd * (q + 1) : r * (q + 1) + (xcd - r) * q) + off; }
        const int nig = WGM * nN, gid = wgid / nig, fm = gid * WGM, gsz = (nM - fm) < WGM ? (nM - fm) : WGM;
        u.pm = fm + ((wgid % nig) % gsz); u.pn = (wgid % nig) / gsz; return true;
    }
};

template <class Epi, bool FLIP>
DI void gemm_phase(int wid_s, LAS unsigned char* lds, const bf16_t* gA, const bf16_t* gBt, int M, int N, int K, const Epi& E) {
    const int tid = phase_tid(wid_s), wid = __builtin_amdgcn_readfirstlane(tid >> 6), lane = tid & 63, wr = wid >> 2, wc = wid & 3, fr = lane & 15, fq = lane >> 4;
    const int nt = K / BK;
    StaticOrder S; S.init(M, N, lndi((int)gridDim.x), lndi(wid_s >> 8));
    unsigned voffA[2], voffB[2];
#pragma unroll
    for (int i = 0; i < 2; ++i) { int R, C; stage_rc(tid * 16 + i * 8192, R, C); const int Rb = Epi::PERM ? ((R & ~31) + perm32(R & 31)) : R;
        voffA[i] = (unsigned)(R * K + C) * 2u; voffB[i] = (unsigned)(Rb * K + C) * 2u; }
    const size_t kstep = (size_t)(BK * 2);
    const size_t hstep = (size_t)HALF * K * 2;
    const size_t tstep = 2 * hstep;
    const unsigned ldsw = (unsigned)wid * 1024u;
    const int aoff = lds_byte(wr * 64 + fr, fq * 8), boff = lds_byte(wc * 32 + fr, fq * 8);
#define PG8_SA(b, h) (((b) * 2 + (h)) * HTB)
#define PG8_SB(b, h) ((4 + (b) * 2 + (h)) * HTB)
#define PG8_STAGE(bufoff, gbase, voff) do { _Pragma("unroll") for (int _i = 0; _i < 2; ++_i) \
        __builtin_amdgcn_global_load_lds((const unsigned*)((const char*)(gbase) + (voff)[_i]), (LAS unsigned*)(lds + (bufoff) + ldsw + _i * 8192), 16, 0, 0); } while (0)
#define PG8_LDA(dst, b, h) do { _Pragma("unroll") for (int m = 0; m < 4; ++m) _Pragma("unroll") for (int k = 0; k < 2; ++k) dst[m][k] = *(const LAS bf16x8*)(lds + PG8_SA(b, h) + aoff + m * 2048 + k * 1024); } while (0)
#define PG8_LDB(dst, b, h) do { _Pragma("unroll") for (int n = 0; n < 2; ++n) _Pragma("unroll") for (int k = 0; k < 2; ++k) dst[n][k] = *(const LAS bf16x8*)(lds + PG8_SB(b, h) + boff + n * 2048 + k * 1024); } while (0)
#define PG8_MMA(ai, bj, At, Bt) do { __builtin_amdgcn_s_setprio(1); _Pragma("unroll") for (int m = 0; m < 4; ++m) _Pragma("unroll") for (int n = 0; n < 2; ++n) _Pragma("unroll") for (int k = 0; k < 2; ++k) \
        acc[ai][bj][m][n] = FLIP ? __builtin_amdgcn_mfma_f32_16x16x32_bf16(At[m][k], Bt[n][k], acc[ai][bj][m][n], 0, 0, 0) \
                                 : __builtin_amdgcn_mfma_f32_16x16x32_bf16(Bt[n][k], At[m][k], acc[ai][bj][m][n], 0, 0, 0); __builtin_amdgcn_s_setprio(0); } while (0)
#define PG8_WAIT_V(n) asm volatile("s_waitcnt vmcnt(" #n ")" ::: "memory")
#define PG8_WAIT_L(n) asm volatile("s_waitcnt lgkmcnt(" #n ")" ::: "memory")
#define PG8_BAR __builtin_amdgcn_s_barrier()
#define PG8_SCHED __builtin_amdgcn_sched_barrier(0)
    Unit cur, nxt; int ui = 0;
    if (!S.next(0, cur)) return;
    f32x4 acc[2][2][4][2];
#pragma unroll
    for (int a = 0; a < 2; ++a)
#pragma unroll
        for (int b = 0; b < 2; ++b)
#pragma unroll
            for (int m = 0; m < 4; ++m)
#pragma unroll
                for (int n = 0; n < 2; ++n) acc[a][b][m][n] = (f32x4){0.f, 0.f, 0.f, 0.f};
    bf16x8 At[4][2], B0[2][2], B1[2][2];
    const char* cA = (const char*)gA + (size_t)cur.pm * tstep; const char* cB = (const char*)gBt + (size_t)cur.pn * tstep;
    PG8_STAGE(PG8_SB(0, 0), cB, voffB); PG8_STAGE(PG8_SB(0, 1), cB + hstep, voffB); PG8_STAGE(PG8_SA(0, 0), cA, voffA); PG8_STAGE(PG8_SA(0, 1), cA + hstep, voffA);
    if (wr == 1) PG8_BAR;
    PG8_WAIT_V(2); PG8_BAR;
    PG8_STAGE(PG8_SB(1, 0), cB + kstep, voffB); PG8_STAGE(PG8_SA(1, 0), cA + kstep, voffA); PG8_STAGE(PG8_SB(1, 1), cB + hstep + kstep, voffB);
    PG8_WAIT_V(6); PG8_BAR;
    for (;;) {
        const bool has_next = S.next(ui + 1, nxt);
        const char* nA = has_next ? (const char*)gA + (size_t)nxt.pm * tstep : cA; const char* nB = has_next ? (const char*)gBt + (size_t)nxt.pn * tstep : cB;
        for (int t = 0; t < nt; t += 2) {
            const bool last = (t == nt - 2);
            const char* a1 = cA + (size_t)(t + 1) * kstep;
            const char* a2 = last ? nA : cA + (size_t)(t + 2) * kstep; const char* b2 = last ? nB : cB + (size_t)(t + 2) * kstep;
            const char* a3 = a2 + kstep; const char* b3 = b2 + kstep;
            PG8_LDB(B0, 0, 0); PG8_LDB(B1, 0, 1); PG8_SCHED; PG8_LDA(At, 0, 0); PG8_STAGE(PG8_SA(1, 1), a1 + hstep, voffA);
            PG8_WAIT_V(8); PG8_WAIT_L(0); PG8_BAR; PG8_MMA(0, 0, At, B0); PG8_MMA(0, 1, At, B1); PG8_BAR; PG8_SCHED;
            PG8_LDA(At, 0, 1); PG8_STAGE(PG8_SB(0, 0), b2, voffB); PG8_STAGE(PG8_SB(0, 1), b2 + hstep, voffB); PG8_STAGE(PG8_SA(0, 0), a2, voffA);
            PG8_WAIT_V(8); PG8_WAIT_L(0); PG8_BAR; PG8_MMA(1, 0, At, B0); PG8_MMA(1, 1, At, B1); PG8_BAR; PG8_SCHED;
            PG8_LDB(B0, 1, 0); PG8_LDB(B1, 1, 1); PG8_SCHED; PG8_LDA(At, 1, 0); PG8_STAGE(PG8_SA(0, 1), a2 + hstep, voffA);
            PG8_WAIT_V(8); PG8_WAIT_L(0); PG8_BAR; PG8_MMA(0, 0, At, B0); PG8_MMA(0, 1, At, B1); PG8_BAR; PG8_SCHED;
            PG8_LDA(At, 1, 1); PG8_STAGE(PG8_SB(1, 0), b3, voffB); PG8_STAGE(PG8_SB(1, 1), b3 + hstep, voffB); PG8_STAGE(PG8_SA(1, 0), a3, voffA);
            PG8_WAIT_V(8); PG8_WAIT_L(0); PG8_BAR; PG8_MMA(1, 0, At, B0); PG8_MMA(1, 1, At, B1); PG8_BAR; PG8_SCHED;
        }
        if (wr == 0) PG8_BAR;
        E(acc, cur, wr, wc, fr, fq);
        if (!has_next) break;
#pragma unroll
        for (int a = 0; a < 2; ++a)
#pragma unroll
            for (int b = 0; b < 2; ++b)
#pragma unroll
                for (int m = 0; m < 4; ++m)
#pragma unroll
                    for (int n = 0; n < 2; ++n) acc[a][b][m][n] = (f32x4){0.f, 0.f, 0.f, 0.f};
        cur = nxt; cA = nA; cB = nB; ++ui;
        if (wr == 1) PG8_BAR;
    }
    PG8_WAIT_V(0);
    PG8_BAR;
#undef PG8_SA
#undef PG8_SB
#undef PG8_STAGE
#undef PG8_LDA
#undef PG8_LDB
#undef PG8_MMA
#undef PG8_WAIT_V
#undef PG8_WAIT_L
#undef PG8_BAR
#undef PG8_SCHED
}

struct EpiGU {
    static constexpr bool PERM = true;
    bf16_t* H; const u64* ss;
    DI void operator()(const f32x4 (&acc)[2][2][4][2], const Unit& u, int wr, int wc, int fr, int fq) const {
        const int row0 = u.pm * BM + wr * 64 + fr, col0 = u.pn * 128 + wc * 32 + 8 * fq;
        u64 sv[2][4];
#pragma unroll
        for (int ai = 0; ai < 2; ++ai)
#pragma unroll
            for (int m = 0; m < 4; ++m) sv[ai][m] = ((const GAS u64*)ss)[row0 + ai * HALF + m * 16];
        __builtin_amdgcn_sched_barrier(0);
#pragma unroll
        for (int ai = 0; ai < 2; ++ai)
#pragma unroll
            for (int m = 0; m < 4; ++m) {
                const int row = row0 + ai * HALF + m * 16;
                const float r = rowscale(sv[ai][m]);
                float h[8];
#pragma unroll
                for (int n = 0; n < 2; ++n)
#pragma unroll
                    for (int j = 0; j < 4; j += 2) {
                        const f32x2 g = (f32x2){acc[ai][0][m][n][j], acc[ai][0][m][n][j + 1]} * r, up = (f32x2){acc[ai][1][m][n][j], acc[ai][1][m][n][j + 1]} * r;
                        const f32x2 t = g * (-LOG2E);
                        f32x2 e; e.x = fexp2(t.x); e.y = fexp2(t.y);
                        const f32x2 d = e + 1.0f;
                        f32x2 rc; rc.x = frcp(d.x); rc.y = frcp(d.y);
                        const f32x2 hv = (g * rc) * up;
                        h[n * 4 + j] = hv.x; h[n * 4 + j + 1] = hv.y;
                    }
                u32x4 w; w.x = cvt_pk_bf16(h[0], h[1]); w.y = cvt_pk_bf16(h[2], h[3]); w.z = cvt_pk_bf16(h[4], h[5]); w.w = cvt_pk_bf16(h[6], h[7]);
                *(GAS u32x4*)(H + (size_t)row * 5632 + col0) = w;
            }
    }
};
struct EpiRes {
    static constexpr bool PERM = true;
    const float* src32; bf16_t* xb; u64* ss; float alpha;
    DI void row_update(const f32x4& x0, const f32x4& x1, const f32x4& a0, const f32x4& a1, size_t off, float& sq) const {
        const f32x4 y0 = x0 + alpha * a0, y1 = x1 + alpha * a1;
        u32x4 w; w.x = cvt_pk_bf16(y0[0], y0[1]); w.y = cvt_pk_bf16(y0[2], y0[3]); w.z = cvt_pk_bf16(y1[0], y1[1]); w.w = cvt_pk_bf16(y1[2], y1[3]);
        *(GAS u32x4*)(xb + off) = w;
        sq += (y0[0] * y0[0] + y0[1] * y0[1]) + (y0[2] * y0[2] + y0[3] * y0[3]) + (y1[0] * y1[0] + y1[1] * y1[1]) + (y1[2] * y1[2] + y1[3] * y1[3]);
    }
    DI void operator()(const f32x4 (&acc)[2][2][4][2], const Unit& u, int wr, int wc, int fr, int fq) const {
        const int row0 = u.pm * BM + wr * 64 + fr, col0 = u.pn * BM + wc * 32 + 8 * fq;
        if (src32) {
#pragma unroll
            for (int ai = 0; ai < 2; ++ai)
#pragma unroll
                for (int m = 0; m < 4; ++m) {
                    const int row = row0 + ai * HALF + m * 16; float sq = 0.f;
#pragma unroll
                    for (int bj = 0; bj < 2; ++bj) {
                        const size_t off = (size_t)row * 2048 + col0 + bj * HALF;
                        const f32x4 x0 = *(const GAS f32x4*)(src32 + off), x1 = *(const GAS f32x4*)(src32 + off + 4);
                        row_update(x0, x1, acc[ai][bj][m][0], acc[ai][bj][m][1], off, sq);
                    }
                    sq += __shfl_xor(sq, 16); sq += __shfl_xor(sq, 32);
                    if (fq == 0) __hip_atomic_fetch_add((GAS u64*)ss + row, ss_fix(sq), __ATOMIC_RELAXED, __HIP_MEMORY_SCOPE_AGENT);
                }
        } else {
            u32x4 xv[2][4][2];
#pragma unroll
            for (int ai = 0; ai < 2; ++ai)
#pragma unroll
                for (int m = 0; m < 4; ++m)
#pragma unroll
                    for (int bj = 0; bj < 2; ++bj) xv[ai][m][bj] = *(const GAS u32x4*)(xb + (size_t)(row0 + ai * HALF + m * 16) * 2048 + col0 + bj * HALF);
            __builtin_amdgcn_sched_barrier(0);
#pragma unroll
            for (int ai = 0; ai < 2; ++ai)
#pragma unroll
                for (int m = 0; m < 4; ++m) {
                    const int row = row0 + ai * HALF + m * 16; float sq = 0.f;
#pragma unroll
                    for (int bj = 0; bj < 2; ++bj) {
                        const size_t off = (size_t)row * 2048 + col0 + bj * HALF; const u32x4 t = xv[ai][m][bj];
                        const f32x4 x0 = (f32x4){__uint_as_float(t.x << 16), __uint_as_float(t.x & 0xffff0000u), __uint_as_float(t.y << 16), __uint_as_float(t.y & 0xffff0000u)};
                        const f32x4 x1 = (f32x4){__uint_as_float(t.z << 16), __uint_as_float(t.z & 0xffff0000u), __uint_as_float(t.w << 16), __uint_as_float(t.w & 0xffff0000u)};
                        row_update(x0, x1, acc[ai][bj][m][0], acc[ai][bj][m][1], off, sq);
                    }
                    sq += __shfl_xor(sq, 16); sq += __shfl_xor(sq, 32);
                    if (fq == 0) __hip_atomic_fetch_add((GAS u64*)ss + row, ss_fix(sq), __ATOMIC_RELAXED, __HIP_MEMORY_SCOPE_AGENT);
                }
        }
    }
};
struct EpiQK {
    static constexpr bool PERM = true;
    bf16_t* QK; const u64* ss; const float* cs; const float* sn; int rope;
    DI void operator()(const f32x4 (&acc)[2][2][4][2], const Unit& u, int wr, int wc, int fr, int fq) const {
        const int row0 = u.pm * BM + wr * 64 + fr, col0 = u.pn * BM + wc * 32 + 8 * fq;
        const bool rot = rope && (wc == 0);
        u64 sv[2][4]; f32x4 cv[2][4], nv[2][4];
#pragma unroll
        for (int ai = 0; ai < 2; ++ai)
#pragma unroll
            for (int m = 0; m < 4; ++m) { const int row = row0 + ai * HALF + m * 16; sv[ai][m] = ((const GAS u64*)ss)[row];
                cv[ai][m] = (f32x4){1.f, 1.f, 1.f, 1.f}; nv[ai][m] = (f32x4){0.f, 0.f, 0.f, 0.f};
                if (rot) { const int pos = row & 2047; cv[ai][m] = *(const GAS f32x4*)(cs + pos * 16 + 4 * fq); nv[ai][m] = *(const GAS f32x4*)(sn + pos * 16 + 4 * fq); } }
        __builtin_amdgcn_sched_barrier(0);
#pragma unroll
        for (int ai = 0; ai < 2; ++ai)
#pragma unroll
            for (int m = 0; m < 4; ++m) {
                const int row = row0 + ai * HALF + m * 16;
                const float r = rowscale(sv[ai][m]);
                const f32x4 c4 = cv[ai][m], s4 = nv[ai][m];
#pragma unroll
                for (int bj = 0; bj < 2; ++bj) {
                    f32x4 v0 = acc[ai][bj][m][0] * r, v1 = acc[ai][bj][m][1] * r;
                    const f32x4 n0 = v0 * c4 - v1 * s4, n1 = v1 * c4 + v0 * s4;
                    u32x4 w; w.x = cvt_pk_bf16(n0[0], n0[1]); w.y = cvt_pk_bf16(n0[2], n0[3]); w.z = cvt_pk_bf16(n1[0], n1[1]); w.w = cvt_pk_bf16(n1[2], n1[3]);
                    { const int hh = 2 * u.pn + bj;
                      *(GAS u32x4*)(QK + ((size_t)((hh >> 4) * 128 + (row >> 11) * 16 + (hh & 15)) * 2048 + (row & 2047)) * 128 + wc * 32 + 8 * fq) = w; }
                }
            }
    }
};
struct EpiVT {
    static constexpr bool PERM = false;
    bf16_t* VT; const u64* ss;
    DI void operator()(const f32x4 (&acc)[2][2][4][2], const Unit& u, int wr, int wc, int fr, int fq) const {
        const int colb = u.pn * BM + wc * 32 + fr;
        u64 sv[2][2][8];
#pragma unroll
        for (int ai = 0; ai < 2; ++ai)
#pragma unroll
            for (int mp = 0; mp < 2; ++mp) { const int tA = u.pm * BM + ai * HALF + wr * 64 + (2 * mp) * 16 + 4 * fq;
#pragma unroll
                for (int j = 0; j < 4; ++j) { sv[ai][mp][j] = ((const GAS u64*)ss)[tA + j]; sv[ai][mp][4 + j] = ((const GAS u64*)ss)[tA + 16 + j]; } }
        __builtin_amdgcn_sched_barrier(0);
#pragma unroll
        for (int ai = 0; ai < 2; ++ai)
#pragma unroll
            for (int mp = 0; mp < 2; ++mp) {
                const int tokb = u.pm * BM + ai * HALF + wr * 64;
                f32x4 rA, rB;
#pragma unroll
                for (int j = 0; j < 4; ++j) { rA[j] = rowscale(sv[ai][mp][j]); rB[j] = rowscale(sv[ai][mp][4 + j]); }
                const int b = tokb >> 11, pos = (tokb & 2047) + 32 * mp + 8 * fq;
#pragma unroll
                for (int bj = 0; bj < 2; ++bj)
#pragma unroll
                    for (int n = 0; n < 2; ++n) {
                        const int col = colb + bj * HALF + n * 16, hh = col >> 7, d = col & 127;
                        const f32x4 vA = acc[ai][bj][2 * mp][n] * rA, vB = acc[ai][bj][2 * mp + 1][n] * rB;
                        u32x4 w; w.x = cvt_pk_bf16(vA[0], vA[1]); w.y = cvt_pk_bf16(vA[2], vA[3]); w.z = cvt_pk_bf16(vB[0], vB[1]); w.w = cvt_pk_bf16(vB[2], vB[3]);
                        *(GAS u32x4*)(VT + ((size_t)(((b * 16 + hh) * 32 + (pos >> 6)) * 128 + d)) * 64 + (pos & 63)) = w;
                    }
            }
    }
};
}

DI int rope_dim_of_pos(int p) { return ((p & 7) < 4) ? (4 * (p >> 3) + (p & 3)) : (16 + 4 * (p >> 3) + (p & 3)); }

DI void convert_item(const float* W, int ldw, int colbase, bool perm, const float* g, bf16_t* WT, int K, int drow0, int kb, LAS unsigned* scr, int lane) {
    const int k0 = 64 * kb, m = lane & 15, kr = lane >> 4;
    const int srccol = colbase + ((perm && m < 8) ? (16 * (m & 1) + 4 * (m >> 1)) : 4 * m);
    const GAS float* src = (const GAS float*)W + (size_t)(k0 + 2 * kr) * ldw + srccol;
    f32x4 v[8][2];
#pragma unroll
    for (int i = 0; i < 8; ++i) { v[i][0] = *(const GAS f32x4*)(src + (size_t)(8 * i) * ldw); v[i][1] = *(const GAS f32x4*)(src + (size_t)(8 * i + 1) * ldw); }
#pragma unroll
    for (int i = 0; i < 8; ++i) {
        float g0 = 1.f, g1 = 1.f;
        if (g) { g0 = ((const GAS float*)g)[k0 + 2 * kr + 8 * i]; g1 = ((const GAS float*)g)[k0 + 2 * kr + 8 * i + 1]; }
        const int kc = kr + 4 * i;
#pragma unroll
        for (int j = 0; j < 4; ++j) scr[36 * (4 * m + j) + ((kc + 4 * m) & 31)] = cvt_pk_bf16(v[i][0][j] * g0, v[i][1][j] * g1);
    }
    asm volatile("s_waitcnt lgkmcnt(0)" ::: "memory");
    const int c = lane & 7;
#pragma unroll
    for (int j = 0; j < 8; ++j) { const int n = (lane >> 3) + 8 * j;
        const u32x4 o = *(const LAS u32x4*)(scr + 36 * n + ((4 * c + 4 * (n >> 2)) & 31));
        *(GAS u32x4*)(WT + (size_t)(drow0 + n) * K + k0 + 8 * c) = o; }
    asm volatile("s_waitcnt lgkmcnt(0)" ::: "memory");
}

DI void phase0(int wid_s, const Params& p, unsigned char* ws, LAS unsigned char* lds) {
    const int tid = phase_tid(wid_s), lane = tid & 63, wave = tid >> 6;
    const int bid = lndi(wid_s >> 8), gdim = lndi((int)gridDim.x);
    const int gw = bid * 8 + wave, NGW = gdim * 8;
    LAS unsigned* scr = (LAS unsigned*)(lds + wave * 9216);
    const float* a_f1g = lnd(p.f1g); const float* a_f1u = lnd(p.f1u); const float* a_f1d = lnd(p.f1d);
    const float* a_f2g = lnd(p.f2g); const float* a_f2u = lnd(p.f2u); const float* a_f2d = lnd(p.f2d);
    const float* a_ewin = lnd(p.ewin); const float* a_ewout = lnd(p.ewout); const float* a_oqkv = lnd(p.oqkv); const float* a_owout = lnd(p.owout);
    const float* a_ng = lnd(p.norm_g); const float* a_x = lnd(p.x);
    constexpr int I_GU = 32 * 176, I_D = 88 * 32, I_QKV = 32 * 96, I_OUT = 32 * 32;
    constexpr int NIT = 4 * I_GU + 4 * I_D + 2 * I_QKV + 2 * I_OUT;
    for (int it = gw; it < NIT; it += NGW) {
        int r = it; const float* W; int ldw, colbase, K, drow0, kb; const float* g = nullptr; bf16_t* WT; bool perm = false;
        if (r < 4 * I_GU) {
            const int q = r / I_GU; r -= q * I_GU; const int layer = q >> 1, ffn = q & 1; kb = r / 176; const int nb = r % 176; drow0 = 64 * nb;
            const int tile = drow0 >> 8, within = drow0 & 255, bj = within >> 7, cc = within & 127;
            const float* gate = ffn ? a_f2g : a_f1g; const float* up = ffn ? a_f2u : a_f1u;
            W = (bj ? up : gate) + (size_t)layer * 2048 * 5632; ldw = 5632; colbase = 128 * tile + cc; K = 2048;
            g = a_ng + (layer * 3 + (ffn ? 2 : 0)) * 2048; WT = (bf16_t*)(ws + WS_WGU + (size_t)q * SZ_WGU);
        } else if ((r -= 4 * I_GU) < 4 * I_D) {
            const int q = r / I_D; r -= q * I_D; const int layer = q >> 1, ffn = q & 1; kb = r / 32; const int nb = r % 32; drow0 = 64 * nb;
            W = (ffn ? a_f2d : a_f1d) + (size_t)layer * 5632 * 2048; ldw = 2048; colbase = drow0; K = 5632; WT = (bf16_t*)(ws + WS_WD + (size_t)q * SZ_WD);
        } else if ((r -= 4 * I_D) < 2 * I_QKV) {
            const int layer = r / I_QKV; r -= layer * I_QKV; kb = r / 96; const int nb = r % 96; drow0 = 64 * nb;
            W = layer ? a_oqkv : a_ewin; ldw = layer ? 6144 : 6152; colbase = drow0; K = 2048; g = a_ng + (layer * 3 + 1) * 2048;
            perm = layer && nb < 64 && (nb & 1) == 0; WT = (bf16_t*)(ws + WS_WQKV + (size_t)layer * SZ_WQKV);
        } else {
            r -= 2 * I_QKV; const int layer = r / I_OUT; r -= layer * I_OUT; kb = r / 32; const int nb = r % 32; drow0 = 64 * nb;
            W = layer ? a_owout : a_ewout; ldw = 2048; colbase = drow0; K = 2048; WT = (bf16_t*)(ws + WS_WOUT + (size_t)layer * SZ_WOUT);
        }
        convert_item(W, ldw, colbase, perm, g, WT, K, drow0, kb, scr, lane);
    }
    {
        u64* ss0 = (u64*)(ws + WS_SS); bf16_t* xb = (bf16_t*)(ws + WS_XB);
        for (int row = gw; row < 16384; row += NGW) {
            const GAS f32x4* xr = (const GAS f32x4*)(a_x + (size_t)row * 2048) + lane;
            GAS u32x2* o = (GAS u32x2*)(xb + (size_t)row * 2048) + lane;
            float sq = 0.f;
#pragma unroll
            for (int j = 0; j < 8; ++j) { const f32x4 v = xr[64 * j]; sq += (v[0] * v[0] + v[1] * v[1]) + (v[2] * v[2] + v[3] * v[3]);
                u32x2 w; w.x = cvt_pk_bf16(v[0], v[1]); w.y = cvt_pk_bf16(v[2], v[3]); o[64 * j] = w; }
#pragma unroll
            for (int o2 = 1; o2 < 64; o2 <<= 1) sq += __shfl_xor(sq, o2);
            if (lane == 0) ((GAS u64*)ss0)[row] = ss_fix(sq);
        }
    }
    const int gt = bid * 512 + tid, NGT = gdim * 512;
    { GAS u64* ss = (GAS u64*)(ws + WS_SS); const u64 zero64 = (u64)(unsigned)lndi(0); for (int i = 16384 + gt; i < 7 * 16384; i += NGT) ss[i] = zero64; }
    { GAS float* cs = (GAS float*)(ws + WS_COS); GAS float* sn = (GAS float*)(ws + WS_SIN);
      for (int i = gt; i < 2048 * 16; i += NGT) { const int pos = i >> 4, fi = i & 15; const float ang = (float)pos * p.freq[fi];
          double rev = (double)ang * 0.15915494309189535; rev -= floor(rev); const float fr = (float)rev;
          cs[i] = __builtin_amdgcn_cosf(fr); sn[i] = __builtin_amdgcn_sinf(fr); } }
    { GAS bf16_t* wf = (GAS bf16_t*)(ws + WS_WF); const GAS float* g1 = (const GAS float*)(a_ng + 1 * 2048);
      for (int i = gt; i < 8 * 2048; i += NGT) { const int j = i >> 11, k = i & 2047; const float v = ((const GAS float*)a_ewin)[(size_t)k * 6152 + 6144 + j] * g1[k];
          wf[i] = (bf16_t)(cvt_pk_bf16(v, 0.f) & 0xffffu); } }
}

DI float bf_lo(unsigned w) { return __uint_as_float(w << 16); }
DI float bf_hi(unsigned w) { return __uint_as_float(w & 0xffff0000u); }
DI void phase_fgate(int wid_s, const Params& p, unsigned char* ws) {
    const int tid = phase_tid(wid_s), lane = tid & 63, wave = tid >> 6;
    const GAS bf16_t* xb = (const GAS bf16_t*)(ws + WS_XB); const GAS bf16_t* wf = (const GAS bf16_t*)(ws + WS_WF);
    const GAS u64* ss1 = (const GAS u64*)(ws + WS_SS) + 1 * 16384; GAS float* logf = (GAS float*)(ws + WS_LOGF);
    const int bid = lndi(wid_s >> 8), gdim = lndi((int)gridDim.x);
    for (int row = bid * 8 + wave; row < 16384; row += gdim * 8) {
        float a[8];
#pragma unroll
        for (int j = 0; j < 8; ++j) a[j] = 0.f;
#pragma unroll
        for (int c = 0; c < 4; ++c) {
            const int k = 512 * c + 8 * lane;
            const u32x4 xv = *(const GAS u32x4*)(xb + (size_t)row * 2048 + k);
            const float x0 = bf_lo(xv.x), x1 = bf_hi(xv.x), x2 = bf_lo(xv.y), x3 = bf_hi(xv.y), x4 = bf_lo(xv.z), x5 = bf_hi(xv.z), x6 = bf_lo(xv.w), x7 = bf_hi(xv.w);
#pragma unroll
            for (int j = 0; j < 8; ++j) { const u32x4 wv = *(const GAS u32x4*)(wf + j * 2048 + k);
                a[j] += (x0 * bf_lo(wv.x) + x1 * bf_hi(wv.x)) + (x2 * bf_lo(wv.y) + x3 * bf_hi(wv.y)) + (x4 * bf_lo(wv.z) + x5 * bf_hi(wv.z)) + (x6 * bf_lo(wv.w) + x7 * bf_hi(wv.w)); }
        }
#pragma unroll
        for (int j = 0; j < 8; ++j) {
#pragma unroll
            for (int o = 1; o < 64; o <<= 1) a[j] += __shfl_xor(a[j], o);
        }
        if (lane < 8) {
            float v = a[0];
#pragma unroll
            for (int j = 1; j < 8; ++j) v = (lane == j) ? a[j] : v;
            v = v * rowscale(ss1[row]) + ((const GAS float*)p.ebf)[lane];
            const float ls = fminf(v, 0.f) - flog2(1.0f + fexp2(-fabsf(v) * LOG2E)) * LN2;
            const int b = row >> 11, s = row & 2047;
            logf[(size_t)(b * 8 + lane) * 2048 + s] = ls;
        }
    }
}

constexpr int KS_STRIDE = 256, VS_STRIDE = 128, VS_OFF = 64 * KS_STRIDE, ABUF = VS_OFF + 128 * VS_STRIDE, CF_OFF = 2 * ABUF, TMP_OFF = CF_OFF + 8192, DTAB_OFF = TMP_OFF + 64, DTAB_LEN = 2148;
#define MFMA16(a, b, c) __builtin_amdgcn_mfma_f32_16x16x32_bf16((a), (b), (c), 0, 0, 0)

template <int MODE, int NCB>
DI void attn_qblock(int wid_s, LAS unsigned char* lds, const bf16_t* qk_, const bf16_t* vt_, bf16_t* ao_, int b, int head, int qb) {
    const int tid = phase_tid(wid_s), wid = __builtin_amdgcn_readfirstlane(tid >> 6), lane = tid & 63, c = lane & 15, q = lane >> 4;
    const int tq0 = qb * (128 * NCB) + 16 * NCB * wid;
    const LAS float* cf = (const LAS float*)(lds + CF_OFF);
    const GAS bf16_t* qk = (const GAS bf16_t*)qk_; const GAS bf16_t* vt = (const GAS bf16_t*)vt_;
    bf16x8 qf[NCB][4];
#pragma unroll
    for (int cb = 0; cb < NCB; ++cb)
#pragma unroll
        for (int ks = 0; ks < 4; ++ks) qf[cb][ks] = *(const GAS bf16x8*)(qk + ((size_t)(b * 16 + head) * 2048 + tq0 + 16 * cb + c) * 128 + 32 * ks + 8 * q);
    f32x4 o[8][NCB];
#pragma unroll
    for (int db = 0; db < 8; ++db)
#pragma unroll
        for (int cb = 0; cb < NCB; ++cb) o[db][cb] = (f32x4){0.f, 0.f, 0.f, 0.f};
    float st_m[2] = {-1e30f, -1e30f}, st_l[2] = {0.f, 0.f};
    float cfq[2] = {0.f, 0.f};
    if (MODE == 1) { cfq[0] = cf[tq0 + c]; if (NCB == 2) cfq[1] = cf[tq0 + 16 + c]; }
    bf16x8 T00, T10, T21, T31, TONE;
    if (MODE == 0) {
#pragma unroll
        for (int j = 0; j < 8; ++j) {
            const int kl = (j < 4) ? (4 * q + j) : (16 + 4 * q + (j - 4));
            T00[j] = (kl > c) ? (short)0x3F80 : (short)0;
            T10[j] = (kl > 16 + c) ? (short)0x3F80 : (short)0;
            T21[j] = (32 + kl > 32 + c) ? (short)0x3F80 : (short)0;
            T31[j] = (32 + kl > 48 + c) ? (short)0x3F80 : (short)0;
            TONE[j] = (short)0x3F80;
        }
    }
    const int nkt = 2 * NCB * (qb + 1);
    const GAS bf16_t* kbase = qk + (size_t)(128 + b * 16 + head) * 2048 * 128;
    const GAS bf16_t* vbase = vt + (size_t)(b * 16 + head) * 32 * 128 * 64;
    const int krow0 = tid >> 4, kc16 = tid & 15, vd0 = tid >> 3, vc8 = tid & 7;
    u32x4 kr[2], vr[2];
#define ATT_ISSUE(kt_) do { const int k0_ = (kt_) * 64; _Pragma("unroll") for (int i_ = 0; i_ < 2; ++i_) { \
        kr[i_] = *(const GAS u32x4*)(kbase + (size_t)(k0_ + krow0 + 32 * i_) * 128 + 8 * kc16); \
        vr[i_] = *(const GAS u32x4*)(vbase + ((size_t)(kt_) * 128 + vd0 + 64 * i_) * 64 + 8 * vc8); } } while (0)
#define ATT_STORE(kt_) do { LAS unsigned char* Kd_ = lds + ((kt_) & 1) * ABUF; LAS unsigned char* Vd_ = Kd_ + VS_OFF; _Pragma("unroll") for (int i_ = 0; i_ < 2; ++i_) { \
        *(LAS u32x4*)(Kd_ + (krow0 + 32 * i_) * KS_STRIDE + 16 * (kc16 ^ (krow0 & 15))) = kr[i_]; *(LAS u32x4*)(Vd_ + (vd0 + 64 * i_) * VS_STRIDE + 16 * (vc8 ^ ((vd0 >> 1) & 7))) = vr[i_]; } } while (0)
#define ATT_BAR() do { asm volatile("s_waitcnt lgkmcnt(0)" ::: "memory"); __builtin_amdgcn_s_barrier(); asm volatile("" ::: "memory"); } while (0)
    ATT_ISSUE(nkt - 1);
    ATT_STORE(nkt - 1);
    ATT_ISSUE(nkt - 2);
    ATT_BAR();
    for (int kt = nkt - 1; kt >= 0; --kt) {
        LAS unsigned char* Ks = lds + (kt & 1) * ABUF; LAS unsigned char* Vs = Ks + VS_OFF;
        const int k0 = kt * 64;
        if (k0 <= tq0 + 16 * NCB - 1) {
            f32x4 s[4][NCB];
#pragma unroll
            for (int rb = 0; rb < 4; ++rb)
#pragma unroll
                for (int cb = 0; cb < NCB; ++cb) s[rb][cb] = (f32x4){0.f, 0.f, 0.f, 0.f};
            constexpr int FB = (NCB == 2) ? ((MODE == 1) ? 2 : 4) : 8, NBAT = 16 / FB;
            bf16x8 frg[2][FB];
#define ATT_LDK(buf_, b_) do { _Pragma("unroll") for (int i_ = 0; i_ < FB; ++i_) { const int f_ = (b_) * FB + i_, ks_ = f_ >> 2, rb_ = f_ & 3; \
                frg[buf_][i_] = *(const LAS bf16x8*)(Ks + (16 * rb_ + c) * KS_STRIDE + 16 * ((4 * ks_ + q) ^ c)); } } while (0)
#define ATT_LDV(buf_, b_) do { _Pragma("unroll") for (int i_ = 0; i_ < FB; ++i_) { const int f_ = (b_) * FB + i_, g_ = f_ >> 3, db_ = f_ & 7; \
                frg[buf_][i_] = *(const LAS bf16x8*)(Vs + (16 * db_ + c) * VS_STRIDE + 16 * ((4 * g_ + q) ^ ((c >> 1) & 7))); } } while (0)
            ATT_LDK(0, 0);
#pragma unroll
            for (int bt = 0; bt < NBAT; ++bt) {
                if (bt + 1 < NBAT) ATT_LDK((bt + 1) & 1, bt + 1);
                __builtin_amdgcn_sched_barrier(0);
#pragma unroll
                for (int i = 0; i < FB; ++i) { const int f = bt * FB + i, ks = f >> 2, rb = f & 3;
#pragma unroll
                    for (int cb = 0; cb < NCB; ++cb) s[rb][cb] = MFMA16(frg[bt & 1][i], qf[cb][ks], s[rb][cb]); }
                __builtin_amdgcn_sched_barrier(0);
            }
            ATT_LDV(0, 0);
            __builtin_amdgcn_sched_barrier(0);
            bf16x8 pf[NCB][2];
#pragma unroll
            for (int cb = 0; cb < NCB; ++cb) {
                const int t = tq0 + 16 * cb + c;
                if (MODE == 0) {
                    float sp[4][4]; float tot = 0.f;
#pragma unroll
                    for (int rb = 0; rb < 4; ++rb)
#pragma unroll
                        for (int h = 0; h < 2; ++h) {
                            f32x2 z = (f32x2){s[rb][cb][2 * h], s[rb][cb][2 * h + 1]} * (SCALE * LOG2E);
                            z.x = fminf(z.x, 120.f); z.y = fminf(z.y, 120.f);
                            f32x2 e; e.x = fexp2(z.x); e.y = fexp2(z.y);
                            const f32x2 d = e + 1.0f;
                            f32x2 l; l.x = flog2(d.x); l.y = flog2(d.y);
                            const int kidx = k0 + 16 * rb + 4 * q + 2 * h;
                            l.x = (kidx < t) ? l.x : 0.f; l.y = (kidx + 1 < t) ? l.y : 0.f;
                            const f32x2 zs = z - l;
                            sp[rb][2 * h] = l.x; sp[rb][2 * h + 1] = l.y; s[rb][cb][2 * h] = zs.x; s[rb][cb][2 * h + 1] = zs.y;
                        }
                    bf16x8 sph[2], spl[2];
#pragma unroll
                    for (int g = 0; g < 2; ++g) {
                        u32x4 hh, ll;
#pragma unroll
                        for (int e = 0; e < 4; ++e) {
                            const int rb = 2 * g + (e >> 1), j0 = 2 * (e & 1);
                            const unsigned hb = cvt_pk_bf16(sp[rb][j0], sp[rb][j0 + 1]);
                            hh[e] = hb; ll[e] = cvt_pk_bf16(sp[rb][j0] - bf_lo(hb), sp[rb][j0 + 1] - bf_hi(hb));
                        }
                        sph[g] = __builtin_bit_cast(bf16x8, hh); spl[g] = __builtin_bit_cast(bf16x8, ll);
                    }
                    f32x4 a[4];
#pragma unroll
                    for (int rs = 0; rs < 4; ++rs) a[rs] = (f32x4){0.f, 0.f, 0.f, 0.f};
                    a[0] = MFMA16(T00, sph[0], a[0]); a[0] = MFMA16(T00, spl[0], a[0]); a[0] = MFMA16(TONE, sph[1], a[0]); a[0] = MFMA16(TONE, spl[1], a[0]);
                    a[1] = MFMA16(T10, sph[0], a[1]); a[1] = MFMA16(T10, spl[0], a[1]); a[1] = MFMA16(TONE, sph[1], a[1]); a[1] = MFMA16(TONE, spl[1], a[1]);
                    a[2] = MFMA16(T21, sph[1], a[2]); a[2] = MFMA16(T21, spl[1], a[2]);
                    a[3] = MFMA16(T31, sph[1], a[3]); a[3] = MFMA16(T31, spl[1], a[3]);
                    { f32x4 t4 = (f32x4){0.f, 0.f, 0.f, 0.f};
                      t4 = MFMA16(TONE, sph[0], t4); t4 = MFMA16(TONE, spl[0], t4); t4 = MFMA16(TONE, sph[1], t4); t4 = MFMA16(TONE, spl[1], t4); tot = t4[0]; }
                    const float carry = st_l[cb];
#pragma unroll
                    for (int rb = 0; rb < 4; ++rb)
#pragma unroll
                        for (int h = 0; h < 2; ++h) {
                            const f32x2 x = ((f32x2){s[rb][cb][2 * h], s[rb][cb][2 * h + 1]} - (f32x2){a[rb][2 * h], a[rb][2 * h + 1]}) - carry;
                            const int kidx = k0 + 16 * rb + 4 * q + 2 * h;
                            const float w0 = fexp2(x.x), w1 = fexp2(x.y);
                            s[rb][cb][2 * h] = (kidx < t) ? w0 : 0.f; s[rb][cb][2 * h + 1] = (kidx + 1 < t) ? w1 : 0.f;
                        }
                    st_l[cb] = carry + tot;
                } else {
                    const int D0 = tq0 - k0;
                    const bool general = (k0 + 63 > tq0);
                    float mx = -1e30f;
                    if (MODE == 1) {
                        const float cq2 = cfq[cb] * LOG2E;
#pragma unroll
                        for (int rb = 0; rb < 4; ++rb) {
                            const f32x4 ck = *(const LAS f32x4*)(cf + k0 + 16 * rb + 4 * q);
#pragma unroll
                            for (int h = 0; h < 2; ++h) { const f32x2 bz = cq2 - (f32x2){ck[2 * h], ck[2 * h + 1]} * LOG2E;
                                const f32x2 z = (f32x2){s[rb][cb][2 * h], s[rb][cb][2 * h + 1]} * (SCALE * LOG2E) + bz; s[rb][cb][2 * h] = z.x; s[rb][cb][2 * h + 1] = z.y; }
                        }
                        if (general) {
#pragma unroll
                            for (int rb = 0; rb < 4; ++rb)
#pragma unroll
                                for (int j = 0; j < 4; ++j) { const int kidx = k0 + 16 * rb + 4 * q + j; s[rb][cb][j] = (kidx <= t) ? s[rb][cb][j] : -1e30f; }
                        }
                    } else {
                        const int mcp = (3 - c) & 3;
                        const LAS float* Rm = (const LAS float*)(lds + DTAB_OFF) + mcp * DTAB_LEN + (2047 - c + 4 * q - mcp);
#pragma unroll
                        for (int rb = 0; rb < 4; ++rb) {
                            const f32x4 b4 = *(const LAS f32x4*)(Rm - (D0 + 16 * (cb - rb)));
#pragma unroll
                            for (int h = 0; h < 2; ++h) { const f32x2 z = (f32x2){s[rb][cb][2 * h], s[rb][cb][2 * h + 1]} * (SCALE * LOG2E) + (f32x2){b4[2 * h], b4[2 * h + 1]};
                                s[rb][cb][2 * h] = z.x; s[rb][cb][2 * h + 1] = z.y; }
                        }
                    }
#pragma unroll
                    for (int rb = 0; rb < 4; ++rb)
#pragma unroll
                        for (int j = 0; j < 4; ++j) mx = fmaxf(mx, s[rb][cb][j]);
                    const bool resc = __any(mx > st_m[cb] + 60.0f);
                    if (resc) { float mr = fmaxf(mx, __shfl_xor(mx, 16)); mr = fmaxf(mr, __shfl_xor(mr, 32));
                        const float mnew2 = fmaxf(st_m[cb], mr), alpha = fexp2(st_m[cb] - mnew2); st_m[cb] = mnew2; st_l[cb] *= alpha;
#pragma unroll
                        for (int db = 0; db < 8; ++db) o[db][cb] *= alpha; }
                    const float mnew = st_m[cb];
                    float sum = 0.f;
#pragma unroll
                    for (int rb = 0; rb < 4; ++rb)
#pragma unroll
                        for (int h = 0; h < 2; ++h) { const f32x2 x = (f32x2){s[rb][cb][2 * h], s[rb][cb][2 * h + 1]} - mnew; s[rb][cb][2 * h] = fexp2(x.x); s[rb][cb][2 * h + 1] = fexp2(x.y); }
                    { f32x2 acc2 = (f32x2){0.f, 0.f};
#pragma unroll
                      for (int rb = 0; rb < 4; ++rb)
#pragma unroll
                          for (int h = 0; h < 2; ++h) acc2 += (f32x2){s[rb][cb][2 * h], s[rb][cb][2 * h + 1]};
                      sum = acc2.x + acc2.y; }
                    st_l[cb] += sum;
                }
#pragma unroll
                for (int g = 0; g < 2; ++g) {
                    u32x4 w; w.x = cvt_pk_bf16(s[2 * g][cb][0], s[2 * g][cb][1]); w.y = cvt_pk_bf16(s[2 * g][cb][2], s[2 * g][cb][3]);
                    w.z = cvt_pk_bf16(s[2 * g + 1][cb][0], s[2 * g + 1][cb][1]); w.w = cvt_pk_bf16(s[2 * g + 1][cb][2], s[2 * g + 1][cb][3]);
                    pf[cb][g] = __builtin_bit_cast(bf16x8, w);
                }
            }
#pragma unroll
            for (int bt = 0; bt < NBAT; ++bt) {
                if (bt + 1 < NBAT) ATT_LDV((bt + 1) & 1, bt + 1);
                __builtin_amdgcn_sched_barrier(0);
#pragma unroll
                for (int i = 0; i < FB; ++i) { const int f = bt * FB + i, g = f >> 3, db = f & 7;
#pragma unroll
                    for (int cb = 0; cb < NCB; ++cb) o[db][cb] = MFMA16(frg[bt & 1][i], pf[cb][g], o[db][cb]); }
                __builtin_amdgcn_sched_barrier(0);
            }
#undef ATT_LDK
#undef ATT_LDV
        }
        if (kt > 0) { ATT_STORE(kt - 1); if (kt > 1) ATT_ISSUE(kt - 2); }
        ATT_BAR();
    }
#undef ATT_ISSUE
#undef ATT_STORE
#undef ATT_BAR
    GAS bf16_t* ao = (GAS bf16_t*)ao_;
#pragma unroll
    for (int cb = 0; cb < NCB; ++cb) {
        float lsum = st_l[cb]; if (MODE != 0) { lsum += __shfl_xor(lsum, 16); lsum += __shfl_xor(lsum, 32); }
        const float inv = (MODE == 0) ? 1.0f : frcp(lsum);
        GAS bf16_t* orow = ao + (size_t)(b * 2048 + tq0 + 16 * cb + c) * 2048 + head * 128 + 4 * q;
#pragma unroll
        for (int db = 0; db < 8; ++db) { const f32x4 v = o[db][cb] * inv; u32x2 w; w.x = cvt_pk_bf16(v[0], v[1]); w.y = cvt_pk_bf16(v[2], v[3]); *(GAS u32x2*)(orow + 16 * db) = w; }
    }
}

DI void fox_cumsum(int wid_s, const float* lf_, LAS unsigned char* lds) {
    const int tid = phase_tid(wid_s), lane = tid & 63, wave = tid >> 6;
    LAS float* cf = (LAS float*)(lds + CF_OFF); LAS float* tmp = (LAS float*)(lds + TMP_OFF);
    __syncthreads();
    f32x4 v = *(const GAS f32x4*)((const GAS float*)lf_ + 4 * tid);
    v[1] += v[0]; v[2] += v[1]; v[3] += v[2];
    const float tot = v[3]; float sc = tot;
#pragma unroll
    for (int o = 1; o < 64; o <<= 1) { const float t = __shfl_up(sc, o); if (lane >= o) sc += t; }
    if (lane == 63) tmp[wave] = sc;
    __syncthreads();
    float base = sc - tot;
    for (int w = 0; w < wave; ++w) base += tmp[w];
    v += base; *(LAS f32x4*)(cf + 4 * tid) = v;
    __syncthreads();
}

DI void phase_attn_even(int wid_s, unsigned char* ws, LAS unsigned char* lds) {
    const bf16_t* qk = (const bf16_t*)(ws + WS_BIG); const bf16_t* vt = (const bf16_t*)(ws + WS_VT); bf16_t* ao = (bf16_t*)(ws + WS_AO);
    const int bid = lndi(wid_s >> 8), gdim = lndi((int)gridDim.x);
    for (int pr = bid; pr < 768; pr += gdim) {
        const int xcd = pr & 7, k = (pr >> 3) & 31;
        if (pr < 512) {
            const int kk = (pr >> 3);
            const int bh = xcd + 8 * (kk >> 3), pi = kk & 7, b = bh >> 3, hh = bh & 7;
            if (ATT_PARTS & 1) for (int half = 0; half < 2; ++half) attn_qblock<0, 1>(wid_s, lds, qk, vt, ao, b, hh, half ? pi : 15 - pi);
        } else {
            const int bh = xcd + 8 * (k >> 2), pi = k & 3, b = bh >> 3, hh = bh & 7;
            fox_cumsum(wid_s, (const float*)(ws + WS_LOGF) + (size_t)(b * 8 + hh) * 2048, lds);
            if (ATT_PARTS & 2) for (int half = 0; half < 2; ++half) attn_qblock<1, 2>(wid_s, lds, qk, vt, ao, b, 8 + hh, half ? pi : 7 - pi);
        }
    }
}
DI void phase_attn_odd(int wid_s, unsigned char* ws, LAS unsigned char* lds) {
    const bf16_t* qk = (const bf16_t*)(ws + WS_BIG); const bf16_t* vt = (const bf16_t*)(ws + WS_VT); bf16_t* ao = (bf16_t*)(ws + WS_AO);
    const int bid = lndi(wid_s >> 8), gdim = lndi((int)gridDim.x);
    {
        const int tid = phase_tid(wid_s); LAS float* tab = (LAS float*)(lds + DTAB_OFF);
        for (int e = tid; e < 4 * DTAB_LEN; e += 512) { const int m = e / DTAB_LEN, x = e - m * DTAB_LEN, d = 2047 - (x + m);
            const int cnt = (d < 0) ? 0 : ((int)(d <= 128) + ((int)((d & 3) == 0) & (int)(d <= 512)) + (int)((d & 15) == 0));
            tab[e] = (cnt == 0) ? -1e30f : ((cnt == 1) ? 0.f : ((cnt == 2) ? 1.0f : 1.5849625f)); }
        __syncthreads();
    }
    for (int pr = bid; pr < 512; pr += gdim) {
        const int xcd = pr & 7, k = pr >> 3;
        const int bh = xcd + 8 * (k >> 2), pi = k & 3, b = bh >> 4, h = bh & 15;
        for (int rep = 0; rep < ((REPEAT_MASK & 128) ? 2 : 1); ++rep)
        for (int half = 0; half < 2; ++half) attn_qblock<2, 2>(wid_s, lds, qk, vt, ao, b, h, half ? pi : 7 - pi);
    }
}

DI void phase_final(int wid_s, const Params& p, unsigned char* ws) {
    const int tid = phase_tid(wid_s), lane = tid & 63, wave = tid >> 6;
    const GAS u64* ss6 = (const GAS u64*)(ws + WS_SS) + 6 * 16384;
    const int bid = lndi(wid_s >> 8), gdim = lndi((int)gridDim.x);
    for (int row = bid * 8 + wave; row < 16384; row += gdim * 8) {
        const float r = rowscale(ss6[row]);
        const GAS u32x4* xr = (const GAS u32x4*)((const GAS bf16_t*)(ws + WS_XB) + (size_t)row * 2048) + lane;
        GAS f32x4* orow = (GAS f32x4*)(p.out + (size_t)row * 2048) + 2 * lane; const GAS f32x4* gr = (const GAS f32x4*)p.fng + 2 * lane;
#pragma unroll
        for (int j = 0; j < 4; ++j) { const u32x4 xv = xr[64 * j];
            const f32x4 a = (f32x4){__uint_as_float(xv.x << 16), __uint_as_float(xv.x & 0xffff0000u), __uint_as_float(xv.y << 16), __uint_as_float(xv.y & 0xffff0000u)};
            const f32x4 b = (f32x4){__uint_as_float(xv.z << 16), __uint_as_float(xv.z & 0xffff0000u), __uint_as_float(xv.w << 16), __uint_as_float(xv.w & 0xffff0000u)};
            orow[128 * j] = a * r * gr[128 * j]; orow[128 * j + 1] = b * r * gr[128 * j + 1]; }
    }
}

#define XB_TMO      128
#define XB_XCNT(j)  (256  + 64 * (j))
#define XB_XSUB(j)  (1280 + 64 * (j))
#define XB_XGEN(j)  (2304 + 64 * (j))
#define XB_TOP      3328
#define XB_TOPGEN   3392
#define XCD_BAR_WORDS 3456
#define XB_SPIN_CAP (1u << 18)
DI unsigned xb_ld(unsigned* p)              { return __hip_atomic_load(p, __ATOMIC_RELAXED, __HIP_MEMORY_SCOPE_AGENT); }
DI unsigned xb_add(unsigned* p, unsigned v) { return __hip_atomic_fetch_add(p, v, __ATOMIC_RELAXED, __HIP_MEMORY_SCOPE_AGENT); }
DI unsigned xb_xcc_id() { return (unsigned)__builtin_amdgcn_s_getreg((3 << 11) | 20) & 0xFu; }
#define XB_SPIN(cond, bar) do { unsigned _sp = 0; while (cond) { __builtin_amdgcn_s_sleep(1); \
    if ((++_sp & 255u) == 0u) { if (xb_ld(&(bar)[XB_TMO])) break; if (_sp > XB_SPIN_CAP) { atomicAdd(&(bar)[XB_TMO], 1u); break; } } } } while (0)
struct XcdBarrier { unsigned* bar; unsigned x; volatile LAS unsigned* st; };
DI XcdBarrier xcd_barrier_post(unsigned* bar, volatile LAS unsigned* st, bool t0) {
    XcdBarrier b; b.bar = bar; b.x = xb_xcc_id(); b.st = st;
    if (t0) st[2] = xb_add(&bar[XB_XCNT(b.x)], 1u);
    return b;
}
DI void xcd_barrier_complete(unsigned* bar, unsigned x, unsigned& nloc, unsigned& nx) {
    const unsigned G = gridDim.x * gridDim.y * gridDim.z;
    unsigned sum, cnt, mine, sp = 0u;
    for (;;) {
        sum = 0u; cnt = 0u; mine = 0u;
#pragma unroll
        for (unsigned j = 0; j < 16; ++j) { const unsigned c = xb_ld(&bar[XB_XCNT(j)]); sum += c; cnt += (c > 0u) ? 1u : 0u; mine = (j == x) ? c : mine; }
        if (sum == G) break;
        __builtin_amdgcn_s_sleep(1);
        if ((++sp & 255u) == 0u) { if (xb_ld(&bar[XB_TMO])) break; if (sp > XB_SPIN_CAP) { atomicAdd(&bar[XB_TMO], 1u); break; } }
    }
    nloc = mine > 0u ? mine : 1u; nx = cnt > 0u ? cnt : 1u;
}
DI unsigned xcd_census_uniform(unsigned* bar) { unsigned ok = 1u, n = 0u;
#pragma unroll
    for (unsigned j = 0; j < 16; ++j) { const unsigned c = xb_ld(&bar[XB_XCNT(j)]); if (c != 0u) { ++n; if (c != 32u) ok = 0u; } }
    return (ok && n == 8u) ? 1u : 0u; }
DI void xcd_barrier(const XcdBarrier& b, int wid_s) {
    asm volatile("s_waitcnt vmcnt(0)" ::: "memory");
    __syncthreads();
    if ((wid_s & 255) == 0 && lane_id() == 0) {
        unsigned* bar = lnd(b.bar); const unsigned bx = (unsigned)lndi((int)b.x);
        __builtin_amdgcn_s_waitcnt(0);
        unsigned nloc = b.st[0], nx = b.st[1];
        if (nloc == 0u) { xcd_barrier_complete(bar, bx, nloc, nx); b.st[0] = nloc; b.st[1] = nx; b.st[3] = xcd_census_uniform(bar); }
        const unsigned old = xb_add(&bar[XB_XSUB(bx)], 1u);
        const unsigned gen = old / nloc;
        if (old + 1u == (gen + 1u) * nloc) {
            __builtin_amdgcn_fence(__ATOMIC_RELEASE, "agent");
            asm volatile("s_waitcnt vmcnt(0)" ::: "memory");
            const unsigned og = xb_add(&bar[XB_TOP], 1u);
            const unsigned tg = og / nx;
            if (og + 1u == (tg + 1u) * nx) xb_add(&bar[XB_TOPGEN], 1u);
            else XB_SPIN(xb_ld(&bar[XB_TOPGEN]) == tg, bar);
            __builtin_amdgcn_fence(__ATOMIC_ACQUIRE, "agent");
            xb_add(&bar[XB_XGEN(bx)], 1u);
            asm volatile("s_waitcnt vmcnt(0)" ::: "memory");
        } else {
            XB_SPIN(xb_ld(&bar[XB_XGEN(bx)]) == gen, bar);
            __builtin_amdgcn_fence(__ATOMIC_ACQUIRE, "agent");
            asm volatile("s_waitcnt vmcnt(0)" ::: "memory");
        }
    }
    __syncthreads();
}
constexpr size_t WS_BAR = 0xE0000;

__global__ void __launch_bounds__(512) mega(Params p) {
    extern __shared__ __attribute__((aligned(16))) unsigned char smem[];
    LAS unsigned char* lds = (LAS unsigned char*)smem;
    if (p.ph_hi > 1000) cg::this_grid().sync();
    int wid_s = __builtin_amdgcn_readfirstlane((int)(threadIdx.x >> 6)) | ((int)blockIdx.x << 8);
    __shared__ uint4 xb_words;
    const bool t0 = ((wid_s & 255) == 0) && (lane_id() == 0);
    if (t0) xb_words = make_uint4(0u, 0u, 0u, 0u);
    __syncthreads();
    const XcdBarrier xb = xcd_barrier_post((unsigned*)(p.ws + WS_BAR), (volatile LAS unsigned*)&xb_words, t0);
    for (int ph = p.ph_lo; ph < p.ph_hi; ++ph) {
        if (ph > p.ph_lo) xcd_barrier(xb, wid_s);
        if (ph == 1 && gridDim.x == 256) {
            const volatile LAS unsigned* stw = (const volatile LAS unsigned*)&xb_words;
            const int okc = __builtin_amdgcn_readfirstlane((int)stw[3]), rank = __builtin_amdgcn_readfirstlane((int)stw[2]);
            if (okc) wid_s = (wid_s & 255) | ((rank * 8 + (int)xb.x) << 8);
        }
        unsigned char* ws = p.ws; asm volatile("" : "+s"(ws));
        bf16_t* xb = (bf16_t*)(ws + WS_XB); bf16_t* ao = (bf16_t*)(ws + WS_AO); bf16_t* hid = (bf16_t*)(ws + WS_BIG);
        bf16_t* qk = (bf16_t*)(ws + WS_BIG); bf16_t* vt = (bf16_t*)(ws + WS_VT); u64* ss = (u64*)(ws + WS_SS);
#if PROBE_A >= 0
        if (blockIdx.x == 0 && wid_s == 0 && lane_id() == 0) ((GAS unsigned long long*)(ws + 0x70000))[ph] = __builtin_amdgcn_s_memrealtime();
#endif
        if (EN_P0 && ph == 0) { phase0(wid_s, p, ws, lds); if (REPEAT_MASK & 1) { __syncthreads(); phase0(wid_s, p, ws, lds); } }
        else if (EN_FIN && ph == 15) { phase_final(wid_s, p, ws); }
        else {
            const int layer = (ph - 1) / 7, sub = (ph - 1) % 7;
            if (EN_GU && (sub == 0 || sub == 5)) {
                const int ffn = sub == 5, q = layer * 2 + ffn, ni = layer * 3 + (ffn ? 2 : 0);
                pg8::EpiGU E{hid, ss + ni * 16384};
                for (int rep = 0; rep < ((REPEAT_MASK & 4) ? 2 : 1); ++rep)
                pg8::gemm_phase<pg8::EpiGU, false>(wid_s, lds, xb, (const bf16_t*)(ws + WS_WGU + (size_t)q * SZ_WGU), 16384, 11264, 2048, E);
            } else if (EN_RES && (sub == 1 || sub == 6 || sub == 4)) {
                const int ffn = sub == 6; const bool isout = sub == 4;
                const int q = layer * 2 + ffn; const int ni = layer * 3 + (isout ? 2 : (ffn ? 3 : 1));
                const float* src = (layer == 0 && sub == 1) ? p.x : nullptr;
                pg8::EpiRes E{src, xb, ss + ni * 16384, isout ? 1.0f : 0.5f};
                const bf16_t* A = isout ? ao : hid; const bf16_t* Bt = isout ? (const bf16_t*)(ws + WS_WOUT + (size_t)layer * SZ_WOUT) : (const bf16_t*)(ws + WS_WD + (size_t)q * SZ_WD);
                pg8::gemm_phase<pg8::EpiRes, false>(wid_s, lds, A, Bt, 16384, 2048, isout ? 2048 : 5632, E);
            } else if (EN_QKV && sub == 2) {
                const int ni = layer * 3 + 1; const bf16_t* W = (const bf16_t*)(ws + WS_WQKV + (size_t)layer * SZ_WQKV);
                pg8::EpiQK E{qk, ss + ni * 16384, (const float*)(ws + WS_COS), (const float*)(ws + WS_SIN), layer};
                for (int rep = 0; rep < ((REPEAT_MASK & 8) ? 2 : 1); ++rep) {
                if (QKV_PARTS & 1) pg8::gemm_phase<pg8::EpiQK, false>(wid_s, lds, xb, W, 16384, 4096, 2048, E);
                pg8::EpiVT E2{vt, ss + ni * 16384};
                if (QKV_PARTS & 2) pg8::gemm_phase<pg8::EpiVT, true>(wid_s, lds, xb, W + (size_t)4096 * 2048, 16384, 2048, 2048, E2); }
                if ((QKV_PARTS & 4) && layer == 0) phase_fgate(wid_s, p, ws);
            } else if (sub == 3) {
                for (int rep = 0; rep < ((REPEAT_MASK & 2) ? 2 : 1); ++rep) {
                if (EN_ATT0 && layer == 0) phase_attn_even(wid_s, ws, lds); else if (EN_ATT1 && layer == 1) phase_attn_odd(wid_s, ws, lds); }
            }
        }
    }
#if PROBE_A >= 0
    __syncthreads();
    if (blockIdx.x == 0 && threadIdx.x == 0) {
        GAS unsigned long long* ts = (GAS unsigned long long*)(p.ws + 0x70000);
        ts[16] = __builtin_amdgcn_s_memrealtime();
        ((GAS float*)p.out)[0] = (float)(ts[PROBE_A1] - ts[PROBE_A]) * 0.01f;
        ((GAS float*)p.out)[1] = (float)(ts[PROBE_B1] - ts[PROBE_B]) * 0.01f;
    }
#endif
}

extern "C" void kernel_launch(void* const* d_in, const int* in_sizes, int n_in, void* d_out, int out_size, void* d_ws, size_t ws_size, hipStream_t stream) {
    static int grid_blocks = 0;
    if (grid_blocks == 0) {
        if (n_in != 14 || ws_size < WS_END) { fprintf(stderr, "kernel_launch: unexpected n_in %d or ws_size %zu (< %zu)\n", n_in, ws_size, (size_t)WS_END); grid_blocks = -1; return; }
        int dev = 0, cus = 0, per_cu = 0;
        hipGetDevice(&dev);
        hipDeviceGetAttribute(&cus, hipDeviceAttributeMultiprocessorCount, dev);
        if (hipFuncSetAttribute((const void*)mega, hipFuncAttributeMaxDynamicSharedMemorySize, LDS_BYTES) != hipSuccess) { fprintf(stderr, "kernel_launch: hipFuncSetAttribute failed\n"); grid_blocks = -1; return; }
        if (hipOccupancyMaxActiveBlocksPerMultiprocessor(&per_cu, (const void*)mega, 512, LDS_BYTES) != hipSuccess || per_cu < 1) { fprintf(stderr, "kernel_launch: occupancy query failed (%d)\n", per_cu); per_cu = 1; (void)hipGetLastError(); }
        grid_blocks = cus * per_cu;
    }
    if (grid_blocks < 0) return;
    Params p; memset(&p, 0, sizeof(p));
    p.x = (const float*)d_in[0]; p.norm_g = (const float*)d_in[1];
    p.f1g = (const float*)d_in[2]; p.f1u = (const float*)d_in[3]; p.f1d = (const float*)d_in[4];
    p.f2g = (const float*)d_in[5]; p.f2u = (const float*)d_in[6]; p.f2d = (const float*)d_in[7];
    p.ewin = (const float*)d_in[8]; p.ebf = (const float*)d_in[9]; p.ewout = (const float*)d_in[10];
    p.oqkv = (const float*)d_in[11]; p.owout = (const float*)d_in[12]; p.fng = (const float*)d_in[13];
    p.out = (float*)d_out; p.ws = (unsigned char*)d_ws;
    for (int i = 0; i < 16; ++i) p.freq[i] = (float)pow(500000.0, -(double)i / 16.0);
#if MK_SINGLE
    p.ph_lo = 0; p.ph_hi = 16;
    if (hipMemsetAsync((char*)d_ws + WS_BAR, 0, 16384, stream) != hipSuccess) { fprintf(stderr, "kernel_launch: memset of barrier words failed\n"); return; }
    void* args[] = {&p};
    hipError_t e = hipLaunchCooperativeKernel((void*)mega, dim3(grid_blocks), dim3(512), args, LDS_BYTES, stream);
    if (e != hipSuccess) fprintf(stderr, "cooperative launch failed: %s (grid %d)\n", hipGetErrorString(e), grid_blocks);
#else
    for (int ph = 0; ph < 16; ++ph) {
        p.ph_lo = ph; p.ph_hi = ph + 1;
        hipLaunchKernelGGL(mega, dim3(grid_blocks), dim3(512), LDS_BYTES, stream, p);
    }
#endif
}
```

```cpp
#include <hip/hip_runtime.h>
#include <hip/hip_cooperative_groups.h>
#include <cstdio>
#include <cstring>
#include <cmath>
namespace cg = cooperative_groups;

#ifndef MK_SINGLE
#define MK_SINGLE 1
#endif

#ifndef EN_P0
#define EN_P0 1
#endif
#ifndef EN_FIN
#define EN_FIN 1
#endif
#ifndef EN_GU
#define EN_GU 1
#endif
#ifndef EN_RES
#define EN_RES 1
#endif
#ifndef EN_QKV
#define EN_QKV 1
#endif
#ifndef EN_ATT0
#define EN_ATT0 1
#endif
#ifndef EN_ATT1
#define EN_ATT1 1
#endif
#ifndef QKV_PARTS
#define QKV_PARTS 7
#endif
#ifndef ATT_PARTS
#define ATT_PARTS 3
#endif
#ifndef REPEAT_MASK
#define REPEAT_MASK 0
#endif
#ifndef PROBE_A
#define PROBE_A -1
#endif
#ifndef PROBE_A1
#define PROBE_A1 (PROBE_A + 1)
#endif
#ifndef PROBE_B
#define PROBE_B 0
#endif
#ifndef PROBE_B1
#define PROBE_B1 (PROBE_B + 1)
#endif
#define LAS __attribute__((address_space(3)))
#define GAS __attribute__((address_space(1)))
#define DI __device__ __forceinline__

typedef unsigned short bf16_t;
typedef short bf16x8 __attribute__((ext_vector_type(8)));
typedef float f32x4 __attribute__((ext_vector_type(4)));
typedef unsigned u32x4 __attribute__((ext_vector_type(4)));
typedef unsigned u32x2 __attribute__((ext_vector_type(2)));
typedef float f32x2 __attribute__((ext_vector_type(2)));

constexpr float EPS = 1e-6f, LOG2E = 1.4426950408889634f, LN2 = 0.6931471805599453f, SCALE = 0.08838834764831845f;
constexpr int LDS_BYTES = 131072;

constexpr size_t WS_SS = 0;
constexpr size_t WS_LOGF = 0x100000;
constexpr size_t WS_COS = 0x180000;
constexpr size_t WS_SIN = 0x1A0000;
constexpr size_t WS_WF = 0x1C0000;
constexpr size_t WS_WGU = 0x200000;
constexpr size_t SZ_WGU = (size_t)11264 * 2048 * 2;
constexpr size_t WS_WD = WS_WGU + 4 * SZ_WGU;
constexpr size_t SZ_WD = (size_t)2048 * 5632 * 2;
constexpr size_t WS_WQKV = WS_WD + 4 * SZ_WD;
constexpr size_t SZ_WQKV = (size_t)6144 * 2048 * 2;
constexpr size_t WS_WOUT = WS_WQKV + 2 * SZ_WQKV;
constexpr size_t SZ_WOUT = (size_t)2048 * 2048 * 2;
constexpr size_t WS_XB = WS_WOUT + 2 * SZ_WOUT;
constexpr size_t SZ_ACT = (size_t)16384 * 2048 * 2;
constexpr size_t WS_AO = WS_XB + SZ_ACT;
constexpr size_t WS_BIG = WS_AO + SZ_ACT;
constexpr size_t WS_VT = WS_BIG + (size_t)16384 * 4096 * 2;
constexpr size_t WS_END = WS_BIG + (size_t)16384 * 6144 * 2;

struct Params {
    const float* x; const float* norm_g;
    const float* f1g; const float* f1u; const float* f1d;
    const float* f2g; const float* f2u; const float* f2d;
    const float* ewin; const float* ebf; const float* ewout;
    const float* oqkv; const float* owout; const float* fng;
    float* out; unsigned char* ws;
    float freq[16];
    int ph_lo, ph_hi;
};

typedef float f32x2c __attribute__((ext_vector_type(2)));
typedef __bf16 bf16x2c __attribute__((ext_vector_type(2)));
DI unsigned cvt_pk_bf16(float lo, float hi) { const bf16x2c v = __builtin_convertvector((f32x2c){lo, hi}, bf16x2c); return __builtin_bit_cast(unsigned, v); }
DI int lane_id() { return (int)__builtin_amdgcn_mbcnt_hi(~0u, __builtin_amdgcn_mbcnt_lo(~0u, 0u)); }
DI int phase_tid(int wid_s) { int t = ((wid_s & 7) << 6) | lane_id(); asm volatile("" : "+v"(t)); return t; }
DI int lndi(int v) { asm volatile("" : "+s"(v)); return v; }
template <class T> DI T* lnd(T* p) { asm volatile("" : "+s"(p)); return p; }
DI float fexp2(float x) { return __builtin_amdgcn_exp2f(x); }
DI float flog2(float x) { return __builtin_amdgcn_logf(x); }
DI float frcp(float x) { return __builtin_amdgcn_rcpf(x); }
typedef unsigned long long u64;
DI float rowscale(u64 ss) { const float f = (float)(unsigned)(ss >> 32) * 4294967296.0f + (float)(unsigned)ss; return __builtin_amdgcn_rsqf(f * (1.0f / (2048.0f * 1048576.0f)) + EPS); }
DI u64 ss_fix(float sq) { return (u64)(sq * 1048576.0f); }

namespace pg8 {
constexpr int BM = 256, BK = 64, HALF = 128, HTB = HALF * BK * 2, STAGE_BYTES = 8 * HTB, NXCD = 8, WGM = 8;
__host__ __device__ __forceinline__ int lds_byte(int r, int c) { const int st = (r >> 4) * 2 + (c >> 5), rr = r & 15, cc = c & 31, ob = rr * 64 + cc * 2; return st * 1024 + (ob ^ (((ob >> 9) & 1) << 5)); }
__host__ __device__ __forceinline__ void stage_rc(int b, int& R, int& C) { const int st = b / 1024, sb = b % 1024, swz = sb ^ (((sb >> 9) & 1) << 5); R = (st >> 1) * 16 + swz / 64; C = (st & 1) * 32 + (swz % 64) / 2; }
__host__ __device__ __forceinline__ int perm32(int rho) { const int n = rho >> 4, i = rho & 15; return 8 * (i >> 2) + 4 * n + (i & 3); }
struct Unit { int pm, pn; };
struct StaticOrder {
    int nM, nN, nwg, G, c;
    __device__ void init(int M, int N, int G_, int c_) { nM = M / BM; nN = N / BM; nwg = nM * nN; G = G_; c = c_; }
    __device__ bool next(int i, Unit& u) const {
        const long L = (long)i * G + c; if (L >= nwg) return false;
        int wgid = (int)L; { const int q = nwg / NXCD, r = nwg % NXCD, xcd = wgid % NXCD, off = wgid / NXCD; wgid = (xcd < r ? xcd * (q + 1) : r * (q + 1) + (xcd - r) * q) + off; }
        const int nig = WGM * nN, gid = wgid / nig, fm = gid * WGM, gsz = (nM - fm) < WGM ? (nM - fm) : WGM;
        u.pm = fm + ((wgid % nig) % gsz); u.pn = (wgid % nig) / gsz; return true;
    }
};

template <class Epi, bool FLIP>
DI void gemm_phase(int wid_s, LAS unsigned char* lds, const bf16_t* gA, const bf16_t* gBt, int M, int N, int K, const Epi& E) {
    const int tid = phase_tid(wid_s), wid = __builtin_amdgcn_readfirstlane(tid >> 6), lane = tid & 63, wr = wid >> 2, wc = wid & 3, fr = lane & 15, fq = lane >> 4;
    const int nt = K / BK;
    StaticOrder S; S.init(M, N, lndi((int)gridDim.x), lndi(wid_s >> 8));
    unsigned voffA[2], voffB[2];
#pragma unroll
    for (int i = 0; i < 2; ++i) { int R, C; stage_rc(tid * 16 + i * 8192, R, C); const int Rb = Epi::PERM ? ((R & ~31) + perm32(R & 31)) : R;
        voffA[i] = (unsigned)(R * K + C) * 2u; voffB[i] = (unsigned)(Rb * K + C) * 2u; }
    const size_t kstep = (size_t)(BK * 2);
    const size_t hstep = (size_t)HALF * K * 2;
    const size_t tstep = 2 * hstep;
    const unsigned ldsw = (unsigned)wid * 1024u;
    const int aoff = lds_byte(wr * 64 + fr, fq * 8), boff = lds_byte(wc * 32 + fr, fq * 8);
#define PG8_SA(b, h) (((b) * 2 + (h)) * HTB)
#define PG8_SB(b, h) ((4 + (b) * 2 + (h)) * HTB)
#define PG8_STAGE(bufoff, gbase, voff) do { _Pragma("unroll") for (int _i = 0; _i < 2; ++_i) \
        __builtin_amdgcn_global_load_lds((const unsigned*)((const char*)(gbase) + (voff)[_i]), (LAS unsigned*)(lds + (bufoff) + ldsw + _i * 8192), 16, 0, 0); } while (0)
#define PG8_LDA(dst, b, h) do { _Pragma("unroll") for (int m = 0; m < 4; ++m) _Pragma("unroll") for (int k = 0; k < 2; ++k) dst[m][k] = *(const LAS bf16x8*)(lds + PG8_SA(b, h) + aoff + m * 2048 + k * 1024); } while (0)
#define PG8_LDB(dst, b, h) do { _Pragma("unroll") for (int n = 0; n < 2; ++n) _Pragma("unroll") for (int k = 0; k < 2; ++k) dst[n][k] = *(const LAS bf16x8*)(lds + PG8_SB(b, h) + boff + n * 2048 + k * 1024); } while (0)
#define PG8_MMA(ai, bj, At, Bt) do { __builtin_amdgcn_s_setprio(1); _Pragma("unroll") for (int m = 0; m < 4; ++m) _Pragma("unroll") for (int n = 0; n < 2; ++n) _Pragma("unroll") for (int k = 0; k < 2; ++k) \
        acc[ai][bj][m][n] = FLIP ? __builtin_amdgcn_mfma_f32_16x16x32_bf16(At[m][k], Bt[n][k], acc[ai][bj][m][n], 0, 0, 0) \
                                 : __builtin_amdgcn_mfma_f32_16x16x32_bf16(Bt[n][k], At[m][k], acc[ai][bj][m][n], 0, 0, 0); __builtin_amdgcn_s_setprio(0); } while (0)
#define PG8_WAIT_V(n) asm volatile("s_waitcnt vmcnt(" #n ")" ::: "memory")
#define PG8_WAIT_L(n) asm volatile("s_waitcnt lgkmcnt(" #n ")" ::: "memory")
#define PG8_BAR __builtin_amdgcn_s_barrier()
#define PG8_SCHED __builtin_amdgcn_sched_barrier(0)
    Unit cur, nxt; int ui = 0;
    if (!S.next(0, cur)) return;
    f32x4 acc[2][2][4][2];
#pragma unroll
    for (int a = 0; a < 2; ++a)
#pragma unroll
        for (int b = 0; b < 2; ++b)
#pragma unroll
            for (int m = 0; m < 4; ++m)
#pragma unroll
                for (int n = 0; n < 2; ++n) acc[a][b][m][n] = (f32x4){0.f, 0.f, 0.f, 0.f};
    bf16x8 At[4][2], B0[2][2], B1[2][2];
    const char* cA = (const char*)gA + (size_t)cur.pm * tstep; const char* cB = (const char*)gBt + (size_t)cur.pn * tstep;
    PG8_STAGE(PG8_SB(0, 0), cB, voffB); PG8_STAGE(PG8_SB(0, 1), cB + hstep, voffB); PG8_STAGE(PG8_SA(0, 0), cA, voffA); PG8_STAGE(PG8_SA(0, 1), cA + hstep, voffA);
    if (wr == 1) PG8_BAR;
    PG8_WAIT_V(2); PG8_BAR;
    PG8_STAGE(PG8_SB(1, 0), cB + kstep, voffB); PG8_STAGE(PG8_SA(1, 0), cA + kstep, voffA); PG8_STAGE(PG8_SB(1, 1), cB + hstep + kstep, voffB);
    PG8_WAIT_V(6); PG8_BAR;
    for (;;) {
        const bool has_next = S.next(ui + 1, nxt);
        const char* nA = has_next ? (const char*)gA + (size_t)nxt.pm * tstep : cA; const char* nB = has_next ? (const char*)gBt + (size_t)nxt.pn * tstep : cB;
        for (int t = 0; t < nt; t += 2) {
            const bool last = (t == nt - 2);
            const char* a1 = cA + (size_t)(t + 1) * kstep;
            const char* a2 = last ? nA : cA + (size_t)(t + 2) * kstep; const char* b2 = last ? nB : cB + (size_t)(t + 2) * kstep;
            const char* a3 = a2 + kstep; const char* b3 = b2 + kstep;
            PG8_LDB(B0, 0, 0); PG8_LDB(B1, 0, 1); PG8_SCHED; PG8_LDA(At, 0, 0); PG8_STAGE(PG8_SA(1, 1), a1 + hstep, voffA);
            PG8_WAIT_V(8); PG8_WAIT_L(0); PG8_BAR; PG8_MMA(0, 0, At, B0); PG8_MMA(0, 1, At, B1); PG8_BAR; PG8_SCHED;
            PG8_LDA(At, 0, 1); PG8_STAGE(PG8_SB(0, 0), b2, voffB); PG8_STAGE(PG8_SB(0, 1), b2 + hstep, voffB); PG8_STAGE(PG8_SA(0, 0), a2, voffA);
            PG8_WAIT_V(8); PG8_WAIT_L(0); PG8_BAR; PG8_MMA(1, 0, At, B0); PG8_MMA(1, 1, At, B1); PG8_BAR; PG8_SCHED;
            PG8_LDB(B0, 1, 0); PG8_LDB(B1, 1, 1); PG8_SCHED; PG8_LDA(At, 1, 0); PG8_STAGE(PG8_SA(0, 1), a2 + hstep, voffA);
            PG8_WAIT_V(8); PG8_WAIT_L(0); PG8_BAR; PG8_MMA(0, 0, At, B0); PG8_MMA(0, 1, At, B1); PG8_BAR; PG8_SCHED;
            PG8_LDA(At, 1, 1); PG8_STAGE(PG8_SB(1, 0), b3, voffB); PG8_STAGE(PG8_SB(1, 1), b3 + hstep, voffB); PG8_STAGE(PG8_SA(1, 0), a3, voffA);
            PG8_WAIT_V(8); PG8_WAIT_L(0); PG8_BAR; PG8_MMA(1, 0, At, B0); PG8_MMA(1, 1, At, B1); PG8_BAR; PG8_SCHED;
        }
        if (wr == 0) PG8_BAR;
        E(acc, cur, wr, wc, fr, fq);
        if (!has_next) break;
#pragma unroll
        for (int a = 0; a < 2; ++a)
#pragma unroll
            for (int b = 0; b < 2; ++b)
#pragma unroll
                for (int m = 0; m < 4; ++m)
#pragma unroll
                    for (int n = 0; n < 2; ++n) acc[a][b][m][n] = (f32x4){0.f, 0.f, 0.f, 0.f};
        cur = nxt; cA = nA; cB = nB; ++ui;
        if (wr == 1) PG8_BAR;
    }
    PG8_WAIT_V(0);
    PG8_BAR;
#undef PG8_SA
#undef PG8_SB
#undef PG8_STAGE
#undef PG8_LDA
#undef PG8_LDB
#undef PG8_MMA
#undef PG8_WAIT_V
#undef PG8_WAIT_L
#undef PG8_BAR
#undef PG8_SCHED
}

struct EpiGU {
    static constexpr bool PERM = true;
    bf16_t* H; const u64* ss;
    DI void operator()(const f32x4 (&acc)[2][2][4][2], const Unit& u, int wr, int wc, int fr, int fq) const {
        const int row0 = u.pm * BM + wr * 64 + fr, col0 = u.pn * 128 + wc * 32 + 8 * fq;
        u64 sv[2][4];
#pragma unroll
        for (int ai = 0; ai < 2; ++ai)
#pragma unroll
            for (int m = 0; m < 4; ++m) sv[ai][m] = ((const GAS u64*)ss)[row0 + ai * HALF + m * 16];
        __builtin_amdgcn_sched_barrier(0);
#pragma unroll
        for (int ai = 0; ai < 2; ++ai)
#pragma unroll
            for (int m = 0; m < 4; ++m) {
                const int row = row0 + ai * HALF + m * 16;
                const float r = rowscale(sv[ai][m]);
                float h[8];
#pragma unroll
                for (int n = 0; n < 2; ++n)
#pragma unroll
                    for (int j = 0; j < 4; j += 2) {
                        const f32x2 g = (f32x2){acc[ai][0][m][n][j], acc[ai][0][m][n][j + 1]} * r, up = (f32x2){acc[ai][1][m][n][j], acc[ai][1][m][n][j + 1]} * r;
                        const f32x2 t = g * (-LOG2E);
                        f32x2 e; e.x = fexp2(t.x); e.y = fexp2(t.y);
                        const f32x2 d = e + 1.0f;
                        f32x2 rc; rc.x = frcp(d.x); rc.y = frcp(d.y);
                        const f32x2 hv = (g * rc) * up;
                        h[n * 4 + j] = hv.x; h[n * 4 + j + 1] = hv.y;
                    }
                u32x4 w; w.x = cvt_pk_bf16(h[0], h[1]); w.y = cvt_pk_bf16(h[2], h[3]); w.z = cvt_pk_bf16(h[4], h[5]); w.w = cvt_pk_bf16(h[6], h[7]);
                *(GAS u32x4*)(H + (size_t)row * 5632 + col0) = w;
            }
    }
};
struct EpiRes {
    static constexpr bool PERM = true;
    const float* src32; bf16_t* xb; u64* ss; float alpha;
    DI void row_update(const f32x4& x0, const f32x4& x1, const f32x4& a0, const f32x4& a1, size_t off, float& sq) const {
        const f32x4 y0 = x0 + alpha * a0, y1 = x1 + alpha * a1;
        u32x4 w; w.x = cvt_pk_bf16(y0[0], y0[1]); w.y = cvt_pk_bf16(y0[2], y0[3]); w.z = cvt_pk_bf16(y1[0], y1[1]); w.w = cvt_pk_bf16(y1[2], y1[3]);
        *(GAS u32x4*)(xb + off) = w;
        sq += (y0[0] * y0[0] + y0[1] * y0[1]) + (y0[2] * y0[2] + y0[3] * y0[3]) + (y1[0] * y1[0] + y1[1] * y1[1]) + (y1[2] * y1[2] + y1[3] * y1[3]);
    }
    DI void operator()(const f32x4 (&acc)[2][2][4][2], const Unit& u, int wr, int wc, int fr, int fq) const {
        const int row0 = u.pm * BM + wr * 64 + fr, col0 = u.pn * BM + wc * 32 + 8 * fq;
        if (src32) {
#pragma unroll
            for (int ai = 0; ai < 2; ++ai)
#pragma unroll
                for (int m = 0; m < 4; ++m) {
                    const int row = row0 + ai * HALF + m * 16; float sq = 0.f;
#pragma unroll
                    for (int bj = 0; bj < 2; ++bj) {
                        const size_t off = (size_t)row * 2048 + col0 + bj * HALF;
                        const f32x4 x0 = *(const GAS f32x4*)(src32 + off), x1 = *(const GAS f32x4*)(src32 + off + 4);
                        row_update(x0, x1, acc[ai][bj][m][0], acc[ai][bj][m][1], off, sq);
                    }
                    sq += __shfl_xor(sq, 16); sq += __shfl_xor(sq, 32);
                    if (fq == 0) __hip_atomic_fetch_add((GAS u64*)ss + row, ss_fix(sq), __ATOMIC_RELAXED, __HIP_MEMORY_SCOPE_AGENT);
                }
        } else {
            u32x4 xv[2][4][2];
#pragma unroll
            for (int ai = 0; ai < 2; ++ai)
#pragma unroll
                for (int m = 0; m < 4; ++m)
#pragma unroll
                    for (int bj = 0; bj < 2; ++bj) xv[ai][m][bj] = *(const GAS u32x4*)(xb + (size_t)(row0 + ai * HALF + m * 16) * 2048 + col0 + bj * HALF);
            __builtin_amdgcn_sched_barrier(0);
#pragma unroll
            for (int ai = 0; ai < 2; ++ai)
#pragma unroll
                for (int m = 0; m < 4; ++m) {
                    const int row = row0 + ai * HALF + m * 16; float sq = 0.f;
#pragma unroll
                    for (int bj = 0; bj < 2; ++bj) {
                        const size_t off = (size_t)row * 2048 + col0 + bj * HALF; const u32x4 t = xv[ai][m][bj];
                        const f32x4 x0 = (f32x4){__uint_as_float(t.x << 16), __uint_as_float(t.x & 0xffff0000u), __uint_as_float(t.y << 16), __uint_as_float(t.y & 0xffff0000u)};
                        const f32x4 x1 = (f32x4){__uint_as_float(t.z << 16), __uint_as_float(t.z & 0xffff0000u), __uint_as_float(t.w << 16), __uint_as_float(t.w & 0xffff0000u)};
                        row_update(x0, x1, acc[ai][bj][m][0], acc[ai][bj][m][1], off, sq);
                    }
                    sq += __shfl_xor(sq, 16); sq += __shfl_xor(sq, 32);
                    if (fq == 0) __hip_atomic_fetch_add((GAS u64*)ss + row, ss_fix(sq), __ATOMIC_RELAXED, __HIP_MEMORY_SCOPE_AGENT);
                }
        }
    }
};
struct EpiQK {
    static constexpr bool PERM = true;
    bf16_t* QK; const u64* ss; const float* cs; const float* sn; int rope;
    DI void operator()(const f32x4 (&acc)[2][2][4][2], const Unit& u, int wr, int wc, int fr, int fq) const {
        const int row0 = u.pm * BM + wr * 64 + fr, col0 = u.pn * BM + wc * 32 + 8 * fq;
        const bool rot = rope && (wc == 0);
        u64 sv[2][4]; f32x4 cv[2][4], nv[2][4];
#pragma unroll
        for (int ai = 0; ai < 2; ++ai)
#pragma unroll
            for (int m = 0; m < 4; ++m) { const int row = row0 + ai * HALF + m * 16; sv[ai][m] = ((const GAS u64*)ss)[row];
                cv[ai][m] = (f32x4){1.f, 1.f, 1.f, 1.f}; nv[ai][m] = (f32x4){0.f, 0.f, 0.f, 0.f};
                if (rot) { const int pos = row & 2047; cv[ai][m] = *(const GAS f32x4*)(cs + pos * 16 + 4 * fq); nv[ai][m] = *(const GAS f32x4*)(sn + pos * 16 + 4 * fq); } }
        __builtin_amdgcn_sched_barrier(0);
#pragma unroll
        for (int ai = 0; ai < 2; ++ai)
#pragma unroll
            for (int m = 0; m < 4; ++m) {
                const int row = row0 + ai * HALF + m * 16;
                const float r = rowscale(sv[ai][m]);
                const f32x4 c4 = cv[ai][m], s4 = nv[ai][m];
#pragma unroll
                for (int bj = 0; bj < 2; ++bj) {
                    f32x4 v0 = acc[ai][bj][m][0] * r, v1 = acc[ai][bj][m][1] * r;
                    const f32x4 n0 = v0 * c4 - v1 * s4, n1 = v1 * c4 + v0 * s4;
                    u32x4 w; w.x = cvt_pk_bf16(n0[0], n0[1]); w.y = cvt_pk_bf16(n0[2], n0[3]); w.z = cvt_pk_bf16(n1[0], n1[1]); w.w = cvt_pk_bf16(n1[2], n1[3]);
                    { const int hh = 2 * u.pn + bj;
                      *(GAS u32x4*)(QK + ((size_t)((hh >> 4) * 128 + (row >> 11) * 16 + (hh & 15)) * 2048 + (row & 2047)) * 128 + wc * 32 + 8 * fq) = w; }
                }
            }
    }
};
struct EpiVT {
    static constexpr bool PERM = false;
    bf16_t* VT; const u64* ss;
    DI void operator()(const f32x4 (&acc)[2][2][4][2], const Unit& u, int wr, int wc, int fr, int fq) const {
        const int colb = u.pn * BM + wc * 32 + fr;
        u64 sv[2][2][8];
#pragma unroll
        for (int ai = 0; ai < 2; ++ai)
#pragma unroll
            for (int mp = 0; mp < 2; ++mp) { const int tA = u.pm * BM + ai * HALF + wr * 64 + (2 * mp) * 16 + 4 * fq;
#pragma unroll
                for (int j = 0; j < 4; ++j) { sv[ai][mp][j] = ((const GAS u64*)ss)[tA + j]; sv[ai][mp][4 + j] = ((const GAS u64*)ss)[tA + 16 + j]; } }
        __builtin_amdgcn_sched_barrier(0);
#pragma unroll
        for (int ai = 0; ai < 2; ++ai)
#pragma unroll
            for (int mp = 0; mp < 2; ++mp) {
                const int tokb = u.pm * BM + ai * HALF + wr * 64;
                f32x4 rA, rB;
#pragma unroll
                for (int j = 0; j < 4; ++j) { rA[j] = rowscale(sv[ai][mp][j]); rB[j] = rowscale(sv[ai][mp][4 + j]); }
                const int b = tokb >> 11, pos = (tokb & 2047) + 32 * mp + 8 * fq;
#pragma unroll
                for (int bj = 0; bj < 2; ++bj)
#pragma unroll
                    for (int n = 0; n < 2; ++n) {
                        const int col = colb + bj * HALF + n * 16, hh = col >> 7, d = col & 127;
                        const f32x4 vA = acc[ai][bj][2 * mp][n] * rA, vB = acc[ai][bj][2 * mp + 1][n] * rB;
                        u32x4 w; w.x = cvt_pk_bf16(vA[0], vA[1]); w.y = cvt_pk_bf16(vA[2], vA[3]); w.z = cvt_pk_bf16(vB[0], vB[1]); w.w = cvt_pk_bf16(vB[2], vB[3]);
                        *(GAS u32x4*)(VT + ((size_t)(((b * 16 + hh) * 32 + (pos >> 6)) * 128 + d)) * 64 + (pos & 63)) = w;
                    }
            }
    }
};
}

DI int rope_dim_of_pos(int p) { return ((p & 7) < 4) ? (4 * (p >> 3) + (p & 3)) : (16 + 4 * (p >> 3) + (p & 3)); }

DI void convert_item(const float* W, int ldw, int colbase, bool perm, const float* g, bf16_t* WT, int K, int drow0, int kb, LAS unsigned* scr, int lane) {
    const int k0 = 64 * kb, m = lane & 15, kr = lane >> 4;
    const int srccol = colbase + ((perm && m < 8) ? (16 * (m & 1) + 4 * (m >> 1)) : 4 * m);
    const GAS float* src = (const GAS float*)W + (size_t)(k0 + 2 * kr) * ldw + srccol;
    f32x4 v[8][2];
#pragma unroll
    for (int i = 0; i < 8; ++i) { v[i][0] = *(const GAS f32x4*)(src + (size_t)(8 * i) * ldw); v[i][1] = *(const GAS f32x4*)(src + (size_t)(8 * i + 1) * ldw); }
#pragma unroll
    for (int i = 0; i < 8; ++i) {
        float g0 = 1.f, g1 = 1.f;
        if (g) { g0 = ((const GAS float*)g)[k0 + 2 * kr + 8 * i]; g1 = ((const GAS float*)g)[k0 + 2 * kr + 8 * i + 1]; }
        const int kc = kr + 4 * i;
#pragma unroll
        for (int j = 0; j < 4; ++j) scr[36 * (4 * m + j) + ((kc + 4 * m) & 31)] = cvt_pk_bf16(v[i][0][j] * g0, v[i][1][j] * g1);
    }
    asm volatile("s_waitcnt lgkmcnt(0)" ::: "memory");
    const int c = lane & 7;
#pragma unroll
    for (int j = 0; j < 8; ++j) { const int n = (lane >> 3) + 8 * j;
        const u32x4 o = *(const LAS u32x4*)(scr + 36 * n + ((4 * c + 4 * (n >> 2)) & 31));
        *(GAS u32x4*)(WT + (size_t)(drow0 + n) * K + k0 + 8 * c) = o; }
    asm volatile("s_waitcnt lgkmcnt(0)" ::: "memory");
}

DI void phase0(int wid_s, const Params& p, unsigned char* ws, LAS unsigned char* lds) {
    const int tid = phase_tid(wid_s), lane = tid & 63, wave = tid >> 6;
    const int bid = lndi(wid_s >> 8), gdim = lndi((int)gridDim.x);
    const int gw = bid * 8 + wave, NGW = gdim * 8;
    LAS unsigned* scr = (LAS unsigned*)(lds + wave * 9216);
    const float* a_f1g = lnd(p.f1g); const float* a_f1u = lnd(p.f1u); const float* a_f1d = lnd(p.f1d);
    const float* a_f2g = lnd(p.f2g); const float* a_f2u = lnd(p.f2u); const float* a_f2d = lnd(p.f2d);
    const float* a_ewin = lnd(p.ewin); const float* a_ewout = lnd(p.ewout); const float* a_oqkv = lnd(p.oqkv); const float* a_owout = lnd(p.owout);
    const float* a_ng = lnd(p.norm_g); const float* a_x = lnd(p.x);
    constexpr int I_GU = 32 * 176, I_D = 88 * 32, I_QKV = 32 * 96, I_OUT = 32 * 32;
    constexpr int NIT = 4 * I_GU + 4 * I_D + 2 * I_QKV + 2 * I_OUT;
    for (int it = gw; it < NIT; it += NGW) {
        int r = it; const float* W; int ldw, colbase, K, drow0, kb; const float* g = nullptr; bf16_t* WT; bool perm = false;
        if (r < 4 * I_GU) {
            const int q = r / I_GU; r -= q * I_GU; const int layer = q >> 1, ffn = q & 1; kb = r / 176; const int nb = r % 176; drow0 = 64 * nb;
            const int tile = drow0 >> 8, within = drow0 & 255, bj = within >> 7, cc = within & 127;
            const float* gate = ffn ? a_f2g : a_f1g; const float* up = ffn ? a_f2u : a_f1u;
            W = (bj ? up : gate) + (size_t)layer * 2048 * 5632; ldw = 5632; colbase = 128 * tile + cc; K = 2048;
            g = a_ng + (layer * 3 + (ffn ? 2 : 0)) * 2048; WT = (bf16_t*)(ws + WS_WGU + (size_t)q * SZ_WGU);
        } else if ((r -= 4 * I_GU) < 4 * I_D) {
            const int q = r / I_D; r -= q * I_D; const int layer = q >> 1, ffn = q & 1; kb = r / 32; const int nb = r % 32; drow0 = 64 * nb;
            W = (ffn ? a_f2d : a_f1d) + (size_t)layer * 5632 * 2048; ldw = 2048; colbase = drow0; K = 5632; WT = (bf16_t*)(ws + WS_WD + (size_t)q * SZ_WD);
        } else if ((r -= 4 * I_D) < 2 * I_QKV) {
            const int layer = r / I_QKV; r -= layer * I_QKV; kb = r / 96; const int nb = r % 96; drow0 = 64 * nb;
            W = layer ? a_oqkv : a_ewin; ldw = layer ? 6144 : 6152; colbase = drow0; K = 2048; g = a_ng + (layer * 3 + 1) * 2048;
            perm = layer && nb < 64 && (nb & 1) == 0; WT = (bf16_t*)(ws + WS_WQKV + (size_t)layer * SZ_WQKV);
        } else {
            r -= 2 * I_QKV; const int layer = r / I_OUT; r -= layer * I_OUT; kb = r / 32; const int nb = r % 32; drow0 = 64 * nb;
            W = layer ? a_owout : a_ewout; ldw = 2048; colbase = drow0; K = 2048; WT = (bf16_t*)(ws + WS_WOUT + (size_t)layer * SZ_WOUT);
        }
        convert_item(W, ldw, colbase, perm, g, WT, K, drow0, kb, scr, lane);
    }
    {
        u64* ss0 = (u64*)(ws + WS_SS); bf16_t* xb = (bf16_t*)(ws + WS_XB);
        for (int row = gw; row < 16384; row += NGW) {
            const GAS f32x4* xr = (const GAS f32x4*)(a_x + (size_t)row * 2048) + lane;
            GAS u32x2* o = (GAS u32x2*)(xb + (size_t)row * 2048) + lane;
            float sq = 0.f;
#pragma unroll
            for (int j = 0; j < 8; ++j) { const f32x4 v = xr[64 * j]; sq += (v[0] * v[0] + v[1] * v[1]) + (v[2] * v[2] + v[3] * v[3]);
                u32x2 w; w.x = cvt_pk_bf16(v[0], v[1]); w.y = cvt_pk_bf16(v[2], v[3]); o[64 * j] = w; }
#pragma unroll
            for (int o2 = 1; o2 < 64; o2 <<= 1) sq += __shfl_xor(sq, o2);
            if (lane == 0) ((GAS u64*)ss0)[row] = ss_fix(sq);
        }
    }
    const int gt = bid * 512 + tid, NGT = gdim * 512;
    { GAS u64* ss = (GAS u64*)(ws + WS_SS); const u64 zero64 = (u64)(unsigned)lndi(0); for (int i = 16384 + gt; i < 7 * 16384; i += NGT) ss[i] = zero64; }
    { GAS float* cs = (GAS float*)(ws + WS_COS); GAS float* sn = (GAS float*)(ws + WS_SIN);
      for (int i = gt; i < 2048 * 16; i += NGT) { const int pos = i >> 4, fi = i & 15; const float ang = (float)pos * p.freq[fi];
          double rev = (double)ang * 0.15915494309189535; rev -= floor(rev); const float fr = (float)rev;
          cs[i] = __builtin_amdgcn_cosf(fr); sn[i] = __builtin_amdgcn_sinf(fr); } }
    { GAS bf16_t* wf = (GAS bf16_t*)(ws + WS_WF); const GAS float* g1 = (const GAS float*)(a_ng + 1 * 2048);
      for (int i = gt; i < 8 * 2048; i += NGT) { const int j = i >> 11, k = i & 2047; const float v = ((const GAS float*)a_ewin)[(size_t)k * 6152 + 6144 + j] * g1[k];
          wf[i] = (bf16_t)(cvt_pk_bf16(v, 0.f) & 0xffffu); } }
}

DI float bf_lo(unsigned w) { return __uint_as_float(w << 16); }
DI float bf_hi(unsigned w) { return __uint_as_float(w & 0xffff0000u); }
DI void phase_fgate(int wid_s, const Params& p, unsigned char* ws) {
    const int tid = phase_tid(wid_s), lane = tid & 63, wave = tid >> 6;
    const GAS bf16_t* xb = (const GAS bf16_t*)(ws + WS_XB); const GAS bf16_t* wf = (const GAS bf16_t*)(ws + WS_WF);
    const GAS u64* ss1 = (const GAS u64*)(ws + WS_SS) + 1 * 16384; GAS float* logf = (GAS float*)(ws + WS_LOGF);
    const int bid = lndi(wid_s >> 8), gdim = lndi((int)gridDim.x);
    for (int row = bid * 8 + wave; row < 16384; row += gdim * 8) {
        float a[8];
#pragma unroll
        for (int j = 0; j < 8; ++j) a[j] = 0.f;
#pragma unroll
        for (int c = 0; c < 4; ++c) {
            const int k = 512 * c + 8 * lane;
            const u32x4 xv = *(const GAS u32x4*)(xb + (size_t)row * 2048 + k);
            const float x0 = bf_lo(xv.x), x1 = bf_hi(xv.x), x2 = bf_lo(xv.y), x3 = bf_hi(xv.y), x4 = bf_lo(xv.z), x5 = bf_hi(xv.z), x6 = bf_lo(xv.w), x7 = bf_hi(xv.w);
#pragma unroll
            for (int j = 0; j < 8; ++j) { const u32x4 wv = *(const GAS u32x4*)(wf + j * 2048 + k);
                a[j] += (x0 * bf_lo(wv.x) + x1 * bf_hi(wv.x)) + (x2 * bf_lo(wv.y) + x3 * bf_hi(wv.y)) + (x4 * bf_lo(wv.z) + x5 * bf_hi(wv.z)) + (x6 * bf_lo(wv.w) + x7 * bf_hi(wv.w)); }
        }
#pragma unroll
        for (int j = 0; j < 8; ++j) {
#pragma unroll
            for (int o = 1; o < 64; o <<= 1) a[j] += __shfl_xor(a[j], o);
        }
        if (lane < 8) {
            float v = a[0];
#pragma unroll
            for (int j = 1; j < 8; ++j) v = (lane == j) ? a[j] : v;
            v = v * rowscale(ss1[row]) + ((const GAS float*)p.ebf)[lane];
            const float ls = fminf(v, 0.f) - flog2(1.0f + fexp2(-fabsf(v) * LOG2E)) * LN2;
            const int b = row >> 11, s = row & 2047;
            logf[(size_t)(b * 8 + lane) * 2048 + s] = ls;
        }
    }
}

constexpr int KS_STRIDE = 256, VS_STRIDE = 128, VS_OFF = 64 * KS_STRIDE, ABUF = VS_OFF + 128 * VS_STRIDE, CF_OFF = 2 * ABUF, TMP_OFF = CF_OFF + 8192, DTAB_OFF = TMP_OFF + 128, DTAB_LEN = 2148;
#define MFMA16(a, b, c) __builtin_amdgcn_mfma_f32_16x16x32_bf16((a), (b), (c), 0, 0, 0)

template <int MODE, int NCB>
DI void attn_qblock(int wid_s, LAS unsigned char* lds, const bf16_t* qk_, const bf16_t* vt_, bf16_t* ao_, int b, int head, int qb) {
    const int tid = phase_tid(wid_s), wid = __builtin_amdgcn_readfirstlane(tid >> 6), lane = tid & 63, c = lane & 15, q = lane >> 4;
    const int tq0 = qb * (128 * NCB) + 16 * NCB * wid;
    const LAS float* cf = (const LAS float*)(lds + CF_OFF);
    const GAS bf16_t* qk = (const GAS bf16_t*)qk_; const GAS bf16_t* vt = (const GAS bf16_t*)vt_;
    bf16x8 qf[NCB][4];
#pragma unroll
    for (int cb = 0; cb < NCB; ++cb)
#pragma unroll
        for (int ks = 0; ks < 4; ++ks) qf[cb][ks] = *(const GAS bf16x8*)(qk + ((size_t)(b * 16 + head) * 2048 + tq0 + 16 * cb + c) * 128 + 32 * ks + 8 * q);
    f32x4 o[8][NCB];
#pragma unroll
    for (int db = 0; db < 8; ++db)
#pragma unroll
        for (int cb = 0; cb < NCB; ++cb) o[db][cb] = (f32x4){0.f, 0.f, 0.f, 0.f};
    float st_m[2] = {-1e30f, -1e30f}, st_l[2] = {0.f, 0.f};
    float cfq[2] = {0.f, 0.f};
    if (MODE == 1) { cfq[0] = cf[tq0 + c]; if (NCB == 2) cfq[1] = cf[tq0 + 16 + c]; }
    bf16x8 T00, T10, T21, T31, TONE;
    if (MODE == 0) {
#pragma unroll
        for (int j = 0; j < 8; ++j) {
            const int kl = (j < 4) ? (4 * q + j) : (16 + 4 * q + (j - 4));
            T00[j] = (kl > c) ? (short)0x3F80 : (short)0;
            T10[j] = (kl > 16 + c) ? (short)0x3F80 : (short)0;
            T21[j] = (32 + kl > 32 + c) ? (short)0x3F80 : (short)0;
            T31[j] = (32 + kl > 48 + c) ? (short)0x3F80 : (short)0;
            TONE[j] = (short)0x3F80;
        }
    }
    const int nkt = 2 * NCB * (qb + 1);
    const GAS bf16_t* kbase = qk + (size_t)(128 + b * 16 + head) * 2048 * 128;
    const GAS bf16_t* vbase = vt + (size_t)(b * 16 + head) * 32 * 128 * 64;
    const int krow0 = tid >> 4, kc16 = tid & 15, vd0 = tid >> 3, vc8 = tid & 7;
    u32x4 kr[2], vr[2];
#define ATT_ISSUE(kt_) do { const int k0_ = (kt_) * 64; _Pragma("unroll") for (int i_ = 0; i_ < 2; ++i_) { \
        kr[i_] = *(const GAS u32x4*)(kbase + (size_t)(k0_ + krow0 + 32 * i_) * 128 + 8 * kc16); \
        vr[i_] = *(const GAS u32x4*)(vbase + ((size_t)(kt_) * 128 + vd0 + 64 * i_) * 64 + 8 * vc8); } } while (0)
#define ATT_STORE(kt_) do { LAS unsigned char* Kd_ = lds + ((kt_) & 1) * ABUF; LAS unsigned char* Vd_ = Kd_ + VS_OFF; _Pragma("unroll") for (int i_ = 0; i_ < 2; ++i_) { \
        *(LAS u32x4*)(Kd_ + (krow0 + 32 * i_) * KS_STRIDE + 16 * (kc16 ^ (krow0 & 15))) = kr[i_]; *(LAS u32x4*)(Vd_ + (vd0 + 64 * i_) * VS_STRIDE + 16 * (vc8 ^ ((vd0 >> 1) & 7))) = vr[i_]; } } while (0)
#define ATT_BAR() do { asm volatile("s_waitcnt lgkmcnt(0)" ::: "memory"); __builtin_amdgcn_s_barrier(); asm volatile("" ::: "memory"); } while (0)
    LAS unsigned* dflag = (LAS unsigned*)(lds + TMP_OFF + 32);
    if (MODE == 0 && lane == 0) { dflag[wid] = 0u; dflag[8 + wid] = 0u; }
    ATT_ISSUE(nkt - 1);
    ATT_STORE(nkt - 1);
    ATT_ISSUE(nkt - 2);
    ATT_BAR();
    for (int kt = nkt - 1; kt >= 0; --kt) {
        if (MODE == 0) {
            const LAS u32x4* fp = (const LAS u32x4*)(dflag + 8 * ((kt + 1) & 1));
            const u32x4 f0 = fp[0], f1 = fp[1];
            const unsigned alld = (f0.x & f0.y & f0.z & f0.w) & (f1.x & f1.y & f1.z & f1.w);
            if (__builtin_amdgcn_readfirstlane((int)alld) != 0) break;
        }
        LAS unsigned char* Ks = lds + (kt & 1) * ABUF; LAS unsigned char* Vs = Ks + VS_OFF;
        const int k0 = kt * 64;
        if (k0 <= tq0 + 16 * NCB - 1) {
            f32x4 s[4][NCB];
#pragma unroll
            for (int rb = 0; rb < 4; ++rb)
#pragma unroll
                for (int cb = 0; cb < NCB; ++cb) s[rb][cb] = (f32x4){0.f, 0.f, 0.f, 0.f};
            constexpr int FB = (NCB == 2) ? ((MODE == 1) ? 2 : 4) : 8, NBAT = 16 / FB;
            bf16x8 frg[2][FB];
#define ATT_LDK(buf_, b_) do { _Pragma("unroll") for (int i_ = 0; i_ < FB; ++i_) { const int f_ = (b_) * FB + i_, ks_ = f_ >> 2, rb_ = f_ & 3; \
                frg[buf_][i_] = *(const LAS bf16x8*)(Ks + (16 * rb_ + c) * KS_STRIDE + 16 * ((4 * ks_ + q) ^ c)); } } while (0)
#define ATT_LDV(buf_, b_) do { _Pragma("unroll") for (int i_ = 0; i_ < FB; ++i_) { const int f_ = (b_) * FB + i_, g_ = f_ >> 3, db_ = f_ & 7; \
                frg[buf_][i_] = *(const LAS bf16x8*)(Vs + (16 * db_ + c) * VS_STRIDE + 16 * ((4 * g_ + q) ^ ((c >> 1) & 7))); } } while (0)
            ATT_LDK(0, 0);
#pragma unroll
            for (int bt = 0; bt < NBAT; ++bt) {
                if (bt + 1 < NBAT) ATT_LDK((bt + 1) & 1, bt + 1);
                __builtin_amdgcn_sched_barrier(0);
#pragma unroll
                for (int i = 0; i < FB; ++i) { const int f = bt * FB + i, ks = f >> 2, rb = f & 3;
#pragma unroll
                    for (int cb = 0; cb < NCB; ++cb) s[rb][cb] = MFMA16(frg[bt & 1][i], qf[cb][ks], s[rb][cb]); }
                __builtin_amdgcn_sched_barrier(0);
            }
            ATT_LDV(0, 0);
            __builtin_amdgcn_sched_barrier(0);
            bf16x8 pf[NCB][2];
#pragma unroll
            for (int cb = 0; cb < NCB; ++cb) {
                const int t = tq0 + 16 * cb + c;
                if (MODE == 0) {
                    float sp[4][4]; float tot = 0.f;
#pragma unroll
                    for (int rb = 0; rb < 4; ++rb)
#pragma unroll
                        for (int h = 0; h < 2; ++h) {
                            f32x2 z = (f32x2){s[rb][cb][2 * h], s[rb][cb][2 * h + 1]} * (SCALE * LOG2E);
                            z.x = fminf(z.x, 120.f); z.y = fminf(z.y, 120.f);
                            f32x2 e; e.x = fexp2(z.x); e.y = fexp2(z.y);
                            const f32x2 d = e + 1.0f;
                            f32x2 l; l.x = flog2(d.x); l.y = flog2(d.y);
                            const int kidx = k0 + 16 * rb + 4 * q + 2 * h;
                            l.x = (kidx < t) ? l.x : 0.f; l.y = (kidx + 1 < t) ? l.y : 0.f;
                            const f32x2 zs = z - l;
                            sp[rb][2 * h] = l.x; sp[rb][2 * h + 1] = l.y; s[rb][cb][2 * h] = zs.x; s[rb][cb][2 * h + 1] = zs.y;
                        }
                    bf16x8 sph[2], spl[2];
#pragma unroll
                    for (int g = 0; g < 2; ++g) {
                        u32x4 hh, ll;
#pragma unroll
                        for (int e = 0; e < 4; ++e) {
                            const int rb = 2 * g + (e >> 1), j0 = 2 * (e & 1);
                            const unsigned hb = cvt_pk_bf16(sp[rb][j0], sp[rb][j0 + 1]);
                            hh[e] = hb; ll[e] = cvt_pk_bf16(sp[rb][j0] - bf_lo(hb), sp[rb][j0 + 1] - bf_hi(hb));
                        }
                        sph[g] = __builtin_bit_cast(bf16x8, hh); spl[g] = __builtin_bit_cast(bf16x8, ll);
                    }
                    f32x4 a[4];
#pragma unroll
                    for (int rs = 0; rs < 4; ++rs) a[rs] = (f32x4){0.f, 0.f, 0.f, 0.f};
                    a[0] = MFMA16(T00, sph[0], a[0]); a[0] = MFMA16(T00, spl[0], a[0]); a[0] = MFMA16(TONE, sph[1], a[0]); a[0] = MFMA16(TONE, spl[1], a[0]);
                    a[1] = MFMA16(T10, sph[0], a[1]); a[1] = MFMA16(T10, spl[0], a[1]); a[1] = MFMA16(TONE, sph[1], a[1]); a[1] = MFMA16(TONE, spl[1], a[1]);
                    a[2] = MFMA16(T21, sph[1], a[2]); a[2] = MFMA16(T21, spl[1], a[2]);
                    a[3] = MFMA16(T31, sph[1], a[3]); a[3] = MFMA16(T31, spl[1], a[3]);
                    { f32x4 t4 = (f32x4){0.f, 0.f, 0.f, 0.f};
                      t4 = MFMA16(TONE, sph[0], t4); t4 = MFMA16(TONE, spl[0], t4); t4 = MFMA16(TONE, sph[1], t4); t4 = MFMA16(TONE, spl[1], t4); tot = t4[0]; }
                    const float carry = st_l[cb];
#pragma unroll
                    for (int rb = 0; rb < 4; ++rb)
#pragma unroll
                        for (int h = 0; h < 2; ++h) {
                            const f32x2 x = ((f32x2){s[rb][cb][2 * h], s[rb][cb][2 * h + 1]} - (f32x2){a[rb][2 * h], a[rb][2 * h + 1]}) - carry;
                            const int kidx = k0 + 16 * rb + 4 * q + 2 * h;
                            const float w0 = fexp2(x.x), w1 = fexp2(x.y);
                            s[rb][cb][2 * h] = (kidx < t) ? w0 : 0.f; s[rb][cb][2 * h + 1] = (kidx + 1 < t) ? w1 : 0.f;
                        }
                    st_l[cb] = carry + tot;
                } else {
                    const int D0 = tq0 - k0;
                    const bool general = (k0 + 63 > tq0);
                    float mx = -1e30f;
                    if (MODE == 1) {
                        const float cq2 = cfq[cb] * LOG2E;
#pragma unroll
                        for (int rb = 0; rb < 4; ++rb) {
                            const f32x4 ck = *(const LAS f32x4*)(cf + k0 + 16 * rb + 4 * q);
#pragma unroll
                            for (int h = 0; h < 2; ++h) { const f32x2 bz = cq2 - (f32x2){ck[2 * h], ck[2 * h + 1]} * LOG2E;
                                const f32x2 z = (f32x2){s[rb][cb][2 * h], s[rb][cb][2 * h + 1]} * (SCALE * LOG2E) + bz; s[rb][cb][2 * h] = z.x; s[rb][cb][2 * h + 1] = z.y; }
                        }
                        if (general) {
#pragma unroll
                            for (int rb = 0; rb < 4; ++rb)
#pragma unroll
                                for (int j = 0; j < 4; ++j) { const int kidx = k0 + 16 * rb + 4 * q + j; s[rb][cb][j] = (kidx <= t) ? s[rb][cb][j] : -1e30f; }
                        }
                    } else {
                        const int mcp = (3 - c) & 3;
                        const LAS float* Rm = (const LAS float*)(lds + DTAB_OFF) + mcp * DTAB_LEN + (2047 - c + 4 * q - mcp);
#pragma unroll
                        for (int rb = 0; rb < 4; ++rb) {
                            const f32x4 b4 = *(const LAS f32x4*)(Rm - (D0 + 16 * (cb - rb)));
#pragma unroll
                            for (int h = 0; h < 2; ++h) { const f32x2 z = (f32x2){s[rb][cb][2 * h], s[rb][cb][2 * h + 1]} * (SCALE * LOG2E) + (f32x2){b4[2 * h], b4[2 * h + 1]};
                                s[rb][cb][2 * h] = z.x; s[rb][cb][2 * h + 1] = z.y; }
                        }
                    }
#pragma unroll
                    for (int rb = 0; rb < 4; ++rb)
#pragma unroll
                        for (int j = 0; j < 4; ++j) mx = fmaxf(mx, s[rb][cb][j]);
                    const bool resc = __any(mx > st_m[cb] + 60.0f);
                    if (resc) { float mr = fmaxf(mx, __shfl_xor(mx, 16)); mr = fmaxf(mr, __shfl_xor(mr, 32));
                        const float mnew2 = fmaxf(st_m[cb], mr), alpha = fexp2(st_m[cb] - mnew2); st_m[cb] = mnew2; st_l[cb] *= alpha;
#pragma unroll
                        for (int db = 0; db < 8; ++db) o[db][cb] *= alpha; }
                    const float mnew = st_m[cb];
                    float sum = 0.f;
#pragma unroll
                    for (int rb = 0; rb < 4; ++rb)
#pragma unroll
                        for (int h = 0; h < 2; ++h) { const f32x2 x = (f32x2){s[rb][cb][2 * h], s[rb][cb][2 * h + 1]} - mnew; s[rb][cb][2 * h] = fexp2(x.x); s[rb][cb][2 * h + 1] = fexp2(x.y); }
                    { f32x2 acc2 = (f32x2){0.f, 0.f};
#pragma unroll
                      for (int rb = 0; rb < 4; ++rb)
#pragma unroll
                          for (int h = 0; h < 2; ++h) acc2 += (f32x2){s[rb][cb][2 * h], s[rb][cb][2 * h + 1]};
                      sum = acc2.x + acc2.y; }
                    st_l[cb] += sum;
                }
#pragma unroll
                for (int g = 0; g < 2; ++g) {
                    u32x4 w; w.x = cvt_pk_bf16(s[2 * g][cb][0], s[2 * g][cb][1]); w.y = cvt_pk_bf16(s[2 * g][cb][2], s[2 * g][cb][3]);
                    w.z = cvt_pk_bf16(s[2 * g + 1][cb][0], s[2 * g + 1][cb][1]); w.w = cvt_pk_bf16(s[2 * g + 1][cb][2], s[2 * g + 1][cb][3]);
                    pf[cb][g] = __builtin_bit_cast(bf16x8, w);
                }
            }
#pragma unroll
            for (int bt = 0; bt < NBAT; ++bt) {
                if (bt + 1 < NBAT) ATT_LDV((bt + 1) & 1, bt + 1);
                __builtin_amdgcn_sched_barrier(0);
#pragma unroll
                for (int i = 0; i < FB; ++i) { const int f = bt * FB + i, g = f >> 3, db = f & 7;
#pragma unroll
                    for (int cb = 0; cb < NCB; ++cb) o[db][cb] = MFMA16(frg[bt & 1][i], pf[cb][g], o[db][cb]); }
                __builtin_amdgcn_sched_barrier(0);
            }
#undef ATT_LDK
#undef ATT_LDV
        }
        if (MODE == 0) { const bool wdone = !__any(st_l[0] <= 140.0f); if (lane == 0) dflag[8 * (kt & 1) + wid] = wdone ? 1u : 0u; }
        if (kt > 0) { ATT_STORE(kt - 1); if (kt > 1) ATT_ISSUE(kt - 2); }
        ATT_BAR();
    }
    if (MODE == 0) ATT_BAR();
#undef ATT_ISSUE
#undef ATT_STORE
#undef ATT_BAR
    GAS bf16_t* ao = (GAS bf16_t*)ao_;
#pragma unroll
    for (int cb = 0; cb < NCB; ++cb) {
        float lsum = st_l[cb]; if (MODE != 0) { lsum += __shfl_xor(lsum, 16); lsum += __shfl_xor(lsum, 32); }
        const float inv = (MODE == 0) ? 1.0f : frcp(lsum);
        GAS bf16_t* orow = ao + (size_t)(b * 2048 + tq0 + 16 * cb + c) * 2048 + head * 128 + 4 * q;
#pragma unroll
        for (int db = 0; db < 8; ++db) { const f32x4 v = o[db][cb] * inv; u32x2 w; w.x = cvt_pk_bf16(v[0], v[1]); w.y = cvt_pk_bf16(v[2], v[3]); *(GAS u32x2*)(orow + 16 * db) = w; }
    }
}

DI void fox_cumsum(int wid_s, const float* lf_, LAS unsigned char* lds) {
    const int tid = phase_tid(wid_s), lane = tid & 63, wave = tid >> 6;
    LAS float* cf = (LAS float*)(lds + CF_OFF); LAS float* tmp = (LAS float*)(lds + TMP_OFF);
    __syncthreads();
    f32x4 v = *(const GAS f32x4*)((const GAS float*)lf_ + 4 * tid);
    v[1] += v[0]; v[2] += v[1]; v[3] += v[2];
    const float tot = v[3]; float sc = tot;
#pragma unroll
    for (int o = 1; o < 64; o <<= 1) { const float t = __shfl_up(sc, o); if (lane >= o) sc += t; }
    if (lane == 63) tmp[wave] = sc;
    __syncthreads();
    float base = sc - tot;
    for (int w = 0; w < wave; ++w) base += tmp[w];
    v += base; *(LAS f32x4*)(cf + 4 * tid) = v;
    __syncthreads();
}

DI void phase_attn_even(int wid_s, unsigned char* ws, LAS unsigned char* lds) {
    const bf16_t* qk = (const bf16_t*)(ws + WS_BIG); const bf16_t* vt = (const bf16_t*)(ws + WS_VT); bf16_t* ao = (bf16_t*)(ws + WS_AO);
    const int bid = lndi(wid_s >> 8), gdim = lndi((int)gridDim.x);
    for (int pr = bid; pr < 768; pr += gdim) {
        const int xcd = pr & 7, k = (pr >> 3) & 31;
        if (pr < 512) {
            const int kk = (pr >> 3);
            const int bh = xcd + 8 * (kk >> 3), pi = kk & 7, b = bh >> 3, hh = bh & 7;
            if (ATT_PARTS & 1) for (int half = 0; half < 2; ++half) attn_qblock<0, 1>(wid_s, lds, qk, vt, ao, b, hh, half ? pi : 15 - pi);
        } else {
            const int bh = xcd + 8 * (k >> 2), pi = k & 3, b = bh >> 3, hh = bh & 7;
            fox_cumsum(wid_s, (const float*)(ws + WS_LOGF) + (size_t)(b * 8 + hh) * 2048, lds);
            if (ATT_PARTS & 2) for (int half = 0; half < 2; ++half) attn_qblock<1, 2>(wid_s, lds, qk, vt, ao, b, 8 + hh, half ? pi : 7 - pi);
        }
    }
}
DI void phase_attn_odd(int wid_s, unsigned char* ws, LAS unsigned char* lds) {
    const bf16_t* qk = (const bf16_t*)(ws + WS_BIG); const bf16_t* vt = (const bf16_t*)(ws + WS_VT); bf16_t* ao = (bf16_t*)(ws + WS_AO);
    const int bid = lndi(wid_s >> 8), gdim = lndi((int)gridDim.x);
    {
        const int tid = phase_tid(wid_s); LAS float* tab = (LAS float*)(lds + DTAB_OFF);
        for (int e = tid; e < 4 * DTAB_LEN; e += 512) { const int m = e / DTAB_LEN, x = e - m * DTAB_LEN, d = 2047 - (x + m);
            const int cnt = (d < 0) ? 0 : ((int)(d <= 128) + ((int)((d & 3) == 0) & (int)(d <= 512)) + (int)((d & 15) == 0));
            tab[e] = (cnt == 0) ? -1e30f : ((cnt == 1) ? 0.f : ((cnt == 2) ? 1.0f : 1.5849625f)); }
        __syncthreads();
    }
    for (int pr = bid; pr < 512; pr += gdim) {
        const int xcd = pr & 7, k = pr >> 3;
        const int bh = xcd + 8 * (k >> 2), pi = k & 3, b = bh >> 4, h = bh & 15;
        for (int rep = 0; rep < ((REPEAT_MASK & 128) ? 2 : 1); ++rep)
        for (int half = 0; half < 2; ++half) attn_qblock<2, 2>(wid_s, lds, qk, vt, ao, b, h, half ? pi : 7 - pi);
    }
}

DI void phase_final(int wid_s, const Params& p, unsigned char* ws) {
    const int tid = phase_tid(wid_s), lane = tid & 63, wave = tid >> 6;
    const GAS u64* ss6 = (const GAS u64*)(ws + WS_SS) + 6 * 16384;
    const int bid = lndi(wid_s >> 8), gdim = lndi((int)gridDim.x);
    for (int row = bid * 8 + wave; row < 16384; row += gdim * 8) {
        const float r = rowscale(ss6[row]);
        const GAS u32x4* xr = (const GAS u32x4*)((const GAS bf16_t*)(ws + WS_XB) + (size_t)row * 2048) + lane;
        GAS f32x4* orow = (GAS f32x4*)(p.out + (size_t)row * 2048) + 2 * lane; const GAS f32x4* gr = (const GAS f32x4*)p.fng + 2 * lane;
#pragma unroll
        for (int j = 0; j < 4; ++j) { const u32x4 xv = xr[64 * j];
            const f32x4 a = (f32x4){__uint_as_float(xv.x << 16), __uint_as_float(xv.x & 0xffff0000u), __uint_as_float(xv.y << 16), __uint_as_float(xv.y & 0xffff0000u)};
            const f32x4 b = (f32x4){__uint_as_float(xv.z << 16), __uint_as_float(xv.z & 0xffff0000u), __uint_as_float(xv.w << 16), __uint_as_float(xv.w & 0xffff0000u)};
            orow[128 * j] = a * r * gr[128 * j]; orow[128 * j + 1] = b * r * gr[128 * j + 1]; }
    }
}

#define XB_TMO      128
#define XB_XCNT(j)  (256  + 64 * (j))
#define XB_XSUB(j)  (1280 + 64 * (j))
#define XB_XGEN(j)  (2304 + 64 * (j))
#define XB_TOP      3328
#define XB_TOPGEN   3392
#define XCD_BAR_WORDS 3456
#define XB_SPIN_CAP (1u << 18)
DI unsigned xb_ld(unsigned* p)              { return __hip_atomic_load(p, __ATOMIC_RELAXED, __HIP_MEMORY_SCOPE_AGENT); }
DI unsigned xb_add(unsigned* p, unsigned v) { return __hip_atomic_fetch_add(p, v, __ATOMIC_RELAXED, __HIP_MEMORY_SCOPE_AGENT); }
DI unsigned xb_xcc_id() { return (unsigned)__builtin_amdgcn_s_getreg((3 << 11) | 20) & 0xFu; }
#define XB_SPIN(cond, bar) do { unsigned _sp = 0; while (cond) { __builtin_amdgcn_s_sleep(1); \
    if ((++_sp & 255u) == 0u) { if (xb_ld(&(bar)[XB_TMO])) break; if (_sp > XB_SPIN_CAP) { atomicAdd(&(bar)[XB_TMO], 1u); break; } } } } while (0)
struct XcdBarrier { unsigned* bar; unsigned x; volatile LAS unsigned* st; };
DI XcdBarrier xcd_barrier_post(unsigned* bar, volatile LAS unsigned* st, bool t0) {
    XcdBarrier b; b.bar = bar; b.x = xb_xcc_id(); b.st = st;
    if (t0) st[2] = xb_add(&bar[XB_XCNT(b.x)], 1u);
    return b;
}
DI void xcd_barrier_complete(unsigned* bar, unsigned x, unsigned& nloc, unsigned& nx) {
    const unsigned G = gridDim.x * gridDim.y * gridDim.z;
    unsigned sum, cnt, mine, sp = 0u;
    for (;;) {
        sum = 0u; cnt = 0u; mine = 0u;
#pragma unroll
        for (unsigned j = 0; j < 16; ++j) { const unsigned c = xb_ld(&bar[XB_XCNT(j)]); sum += c; cnt += (c > 0u) ? 1u : 0u; mine = (j == x) ? c : mine; }
        if (sum == G) break;
        __builtin_amdgcn_s_sleep(1);
        if ((++sp & 255u) == 0u) { if (xb_ld(&bar[XB_TMO])) break; if (sp > XB_SPIN_CAP) { atomicAdd(&bar[XB_TMO], 1u); break; } }
    }
    nloc = mine > 0u ? mine : 1u; nx = cnt > 0u ? cnt : 1u;
}
DI unsigned xcd_census_uniform(unsigned* bar) { unsigned ok = 1u, n = 0u;
#pragma unroll
    for (unsigned j = 0; j < 16; ++j) { const unsigned c = xb_ld(&bar[XB_XCNT(j)]); if (c != 0u) { ++n; if (c != 32u) ok = 0u; } }
    return (ok && n == 8u) ? 1u : 0u; }
DI void xcd_barrier(const XcdBarrier& b, int wid_s) {
    asm volatile("s_waitcnt vmcnt(0)" ::: "memory");
    __syncthreads();
    if ((wid_s & 255) == 0 && lane_id() == 0) {
        unsigned* bar = lnd(b.bar); const unsigned bx = (unsigned)lndi((int)b.x);
        __builtin_amdgcn_s_waitcnt(0);
        unsigned nloc = b.st[0], nx = b.st[1];
        if (nloc == 0u) { xcd_barrier_complete(bar, bx, nloc, nx); b.st[0] = nloc; b.st[1] = nx; b.st[3] = xcd_census_uniform(bar); }
        const unsigned old = xb_add(&bar[XB_XSUB(bx)], 1u);
        const unsigned gen = old / nloc;
        if (old + 1u == (gen + 1u) * nloc) {
            __builtin_amdgcn_fence(__ATOMIC_RELEASE, "agent");
            asm volatile("s_waitcnt vmcnt(0)" ::: "memory");
            const unsigned og = xb_add(&bar[XB_TOP], 1u);
            const unsigned tg = og / nx;
            if (og + 1u == (tg + 1u) * nx) xb_add(&bar[XB_TOPGEN], 1u);
            else XB_SPIN(xb_ld(&bar[XB_TOPGEN]) == tg, bar);
            __builtin_amdgcn_fence(__ATOMIC_ACQUIRE, "agent");
            xb_add(&bar[XB_XGEN(bx)], 1u);
            asm volatile("s_waitcnt vmcnt(0)" ::: "memory");
        } else {
            XB_SPIN(xb_ld(&bar[XB_XGEN(bx)]) == gen, bar);
            __builtin_amdgcn_fence(__ATOMIC_ACQUIRE, "agent");
            asm volatile("s_waitcnt vmcnt(0)" ::: "memory");
        }
    }
    __syncthreads();
}
constexpr size_t WS_BAR = 0xE0000;

__global__ void __launch_bounds__(512) mega(Params p) {
    extern __shared__ __attribute__((aligned(16))) unsigned char smem[];
    LAS unsigned char* lds = (LAS unsigned char*)smem;
    if (p.ph_hi > 1000) cg::this_grid().sync();
    int wid_s = __builtin_amdgcn_readfirstlane((int)(threadIdx.x >> 6)) | ((int)blockIdx.x << 8);
    __shared__ uint4 xb_words;
    const bool t0 = ((wid_s & 255) == 0) && (lane_id() == 0);
    if (t0) xb_words = make_uint4(0u, 0u, 0u, 0u);
    __syncthreads();
    const XcdBarrier xb = xcd_barrier_post((unsigned*)(p.ws + WS_BAR), (volatile LAS unsigned*)&xb_words, t0);
    for (int ph = p.ph_lo; ph < p.ph_hi; ++ph) {
        if (ph > p.ph_lo) xcd_barrier(xb, wid_s);
        if (ph == 1 && gridDim.x == 256) {
            const volatile LAS unsigned* stw = (const volatile LAS unsigned*)&xb_words;
            const int okc = __builtin_amdgcn_readfirstlane((int)stw[3]), rank = __builtin_amdgcn_readfirstlane((int)stw[2]);
            if (okc) wid_s = (wid_s & 255) | ((rank * 8 + (int)xb.x) << 8);
        }
        unsigned char* ws = p.ws; asm volatile("" : "+s"(ws));
        bf16_t* xb = (bf16_t*)(ws + WS_XB); bf16_t* ao = (bf16_t*)(ws + WS_AO); bf16_t* hid = (bf16_t*)(ws + WS_BIG);
        bf16_t* qk = (bf16_t*)(ws + WS_BIG); bf16_t* vt = (bf16_t*)(ws + WS_VT); u64* ss = (u64*)(ws + WS_SS);
#if PROBE_A >= 0
        if (blockIdx.x == 0 && wid_s == 0 && lane_id() == 0) ((GAS unsigned long long*)(ws + 0x70000))[ph] = __builtin_amdgcn_s_memrealtime();
#endif
        if (EN_P0 && ph == 0) { phase0(wid_s, p, ws, lds); if (REPEAT_MASK & 1) { __syncthreads(); phase0(wid_s, p, ws, lds); } }
        else if (EN_FIN && ph == 15) { phase_final(wid_s, p, ws); }
        else {
            const int layer = (ph - 1) / 7, sub = (ph - 1) % 7;
            if (EN_GU && (sub == 0 || sub == 5)) {
                const int ffn = sub == 5, q = layer * 2 + ffn, ni = layer * 3 + (ffn ? 2 : 0);
                pg8::EpiGU E{hid, ss + ni * 16384};
                for (int rep = 0; rep < ((REPEAT_MASK & 4) ? 2 : 1); ++rep)
                pg8::gemm_phase<pg8::EpiGU, false>(wid_s, lds, xb, (const bf16_t*)(ws + WS_WGU + (size_t)q * SZ_WGU), 16384, 11264, 2048, E);
            } else if (EN_RES && (sub == 1 || sub == 6 || sub == 4)) {
                const int ffn = sub == 6; const bool isout = sub == 4;
                const int q = layer * 2 + ffn; const int ni = layer * 3 + (isout ? 2 : (ffn ? 3 : 1));
                const float* src = (layer == 0 && sub == 1) ? p.x : nullptr;
                pg8::EpiRes E{src, xb, ss + ni * 16384, isout ? 1.0f : 0.5f};
                const bf16_t* A = isout ? ao : hid; const bf16_t* Bt = isout ? (const bf16_t*)(ws + WS_WOUT + (size_t)layer * SZ_WOUT) : (const bf16_t*)(ws + WS_WD + (size_t)q * SZ_WD);
                pg8::gemm_phase<pg8::EpiRes, false>(wid_s, lds, A, Bt, 16384, 2048, isout ? 2048 : 5632, E);
            } else if (EN_QKV && sub == 2) {
                const int ni = layer * 3 + 1; const bf16_t* W = (const bf16_t*)(ws + WS_WQKV + (size_t)layer * SZ_WQKV);
                pg8::EpiQK E{qk, ss + ni * 16384, (const float*)(ws + WS_COS), (const float*)(ws + WS_SIN), layer};
                for (int rep = 0; rep < ((REPEAT_MASK & 8) ? 2 : 1); ++rep) {
                if (QKV_PARTS & 1) pg8::gemm_phase<pg8::EpiQK, false>(wid_s, lds, xb, W, 16384, 4096, 2048, E);
                pg8::EpiVT E2{vt, ss + ni * 16384};
                if (QKV_PARTS & 2) pg8::gemm_phase<pg8::EpiVT, true>(wid_s, lds, xb, W + (size_t)4096 * 2048, 16384, 2048, 2048, E2); }
                if ((QKV_PARTS & 4) && layer == 0) phase_fgate(wid_s, p, ws);
            } else if (sub == 3) {
                for (int rep = 0; rep < ((REPEAT_MASK & 2) ? 2 : 1); ++rep) {
                if (EN_ATT0 && layer == 0) phase_attn_even(wid_s, ws, lds); else if (EN_ATT1 && layer == 1) phase_attn_odd(wid_s, ws, lds); }
            }
        }
    }
#if PROBE_A >= 0
    __syncthreads();
    if (blockIdx.x == 0 && threadIdx.x == 0) {
        GAS unsigned long long* ts = (GAS unsigned long long*)(p.ws + 0x70000);
        ts[16] = __builtin_amdgcn_s_memrealtime();
        ((GAS float*)p.out)[0] = (float)(ts[PROBE_A1] - ts[PROBE_A]) * 0.01f;
        ((GAS float*)p.out)[1] = (float)(ts[PROBE_B1] - ts[PROBE_B]) * 0.01f;
    }
#endif
}

extern "C" void kernel_launch(void* const* d_in, const int* in_sizes, int n_in, void* d_out, int out_size, void* d_ws, size_t ws_size, hipStream_t stream) {
    static int grid_blocks = 0;
    if (grid_blocks == 0) {
        if (n_in != 14 || ws_size < WS_END) { fprintf(stderr, "kernel_launch: unexpected n_in %d or ws_size %zu (< %zu)\n", n_in, ws_size, (size_t)WS_END); grid_blocks = -1; return; }
        int dev = 0, cus = 0, per_cu = 0;
        hipGetDevice(&dev);
        hipDeviceGetAttribute(&cus, hipDeviceAttributeMultiprocessorCount, dev);
        if (hipFuncSetAttribute((const void*)mega, hipFuncAttributeMaxDynamicSharedMemorySize, LDS_BYTES) != hipSuccess) { fprintf(stderr, "kernel_launch: hipFuncSetAttribute failed\n"); grid_blocks = -1; return; }
        if (hipOccupancyMaxActiveBlocksPerMultiprocessor(&per_cu, (const void*)mega, 512, LDS_BYTES) != hipSuccess || per_cu < 1) { fprintf(stderr, "kernel_launch: occupancy query failed (%d)\n", per_cu); per_cu = 1; (void)hipGetLastError(); }
        grid_blocks = cus * per_cu;
    }
    if (grid_blocks < 0) return;
    Params p; memset(&p, 0, sizeof(p));
    p.x = (const float*)d_in[0]; p.norm_g = (const float*)d_in[1];
    p.f1g = (const float*)d_in[2]; p.f1u = (const float*)d_in[3]; p.f1d = (const float*)d_in[4];
    p.f2g = (const float*)d_in[5]; p.f2u = (const float*)d_in[6]; p.f2d = (const float*)d_in[7];
    p.ewin = (const float*)d_in[8]; p.ebf = (const float*)d_in[9]; p.ewout = (const float*)d_in[10];
    p.oqkv = (const float*)d_in[11]; p.owout = (const float*)d_in[12]; p.fng = (const float*)d_in[13];
    p.out = (float*)d_out; p.ws = (unsigned char*)d_ws;
    for (int i = 0; i < 16; ++i) p.freq[i] = (float)pow(500000.0, -(double)i / 16.0);
#if MK_SINGLE
    p.ph_lo = 0; p.ph_hi = 16;
    if (hipMemsetAsync((char*)d_ws + WS_BAR, 0, 16384, stream) != hipSuccess) { fprintf(stderr, "kernel_launch: memset of barrier words failed\n"); return; }
    void* args[] = {&p};
    hipError_t e = hipLaunchCooperativeKernel((void*)mega, dim3(grid_blocks), dim3(512), args, LDS_BYTES, stream);
    if (e != hipSuccess) fprintf(stderr, "cooperative launch failed: %s (grid %d)\n", hipGetErrorString(e), grid_blocks);
#else
    for (int ph = 0; ph < 16; ++ph) {
        p.ph_lo = ph; p.ph_hi = ph + 1;
        hipLaunchKernelGGL(mega, dim3(grid_blocks), dim3(512), LDS_BYTES, stream, p);
    }
#endif
}
```
